# Optimizing an MI355X kernel written in HIP

```python
import math
import jax, jax.numpy as jnp
from jax import lax
import numpy as np

D_MODEL = 2048
BATCH = 1
SEQ = 8192
DEPTH = 2

D_MIX = D_MODEL
BR = D_MIX // 4
CONV_A_WIDTH = 3
ATT_HEADS = 8
ATT_HEAD_DIM = BR // ATT_HEADS
DILATIONS = ((128, 1), (512, 4), (2048, 16))
BLK = 128
REL_BUCKETS = 32
REL_MAX_DIST = 2048
LRU_HEADS = 8
LRU_HEAD_DIM = BR // LRU_HEADS
CONV_C_WIDTH = 4
LRU_C = 8.0
S5_CH = 16
S5_GROUPS = BR // S5_CH
S5_STATE = 64
N_IN = 4 * BR + 4 * BR + 2 * BR + 2 * BR
ALPHA = (2 * DEPTH) ** 0.25
BETA = (8 * DEPTH) ** -0.25
LN_EPS = 1e-5

kernel_name = "hybrid_parallel_conv_dilattn_rglru_s5"


def layer_norm(x, g, b):
    xf = x.astype(jnp.float32)
    mu = jnp.mean(xf, axis=-1, keepdims=True)
    var = jnp.mean(jnp.square(xf - mu), axis=-1, keepdims=True)
    return ((xf - mu) * lax.rsqrt(var + LN_EPS)).astype(x.dtype) * g + b


def causal_dwconv(x, w):
    K = w.shape[0]
    S = x.shape[1]
    xp = jnp.pad(x, ((0, 0), (K - 1, 0), (0, 0)))
    y = xp[:, :S] * w[0]
    for j in range(1, K):
        y = y + xp[:, j:j + S] * w[j]
    return y


def t5_bucket(dist):
    max_exact = REL_BUCKETS // 2
    nf = jnp.maximum(dist, 1).astype(jnp.float32)
    large = max_exact + (jnp.log(nf / max_exact) / math.log(REL_MAX_DIST / max_exact)
                         * (REL_BUCKETS - max_exact)).astype(jnp.int32)
    large = jnp.minimum(large, REL_BUCKETS - 1)
    return jnp.where(dist < max_exact, dist, large)


def dilated_group(q, k, v, rel_bias, window, dil):
    Bsz, S, H, hd = q.shape
    span = window // dil
    assert span <= BLK
    unit = dil * BLK
    S_pad = -(-S // unit) * unit
    nb = S_pad // unit
    pad = ((0, 0), (0, S_pad - S), (0, 0), (0, 0))

    def split(t):
        return jnp.pad(t, pad).reshape(Bsz, nb, BLK, dil, H, hd)

    def with_prev(t):
        prev = jnp.pad(t, ((0, 0), (1, 0), (0, 0), (0, 0), (0, 0), (0, 0)))[:, :-1]
        return jnp.concatenate([prev, t], axis=2)

    qb = split(q)
    kk = with_prev(split(k))
    vv = with_prev(split(v))
    s = jnp.einsum('bnirhd,bnjrhd->bnrhij', qb, kk).astype(jnp.float32)

    i = jnp.arange(BLK)[:, None]
    j = jnp.arange(2 * BLK)[None, :]
    delta = i + BLK - j
    bucket = t5_bucket(jnp.clip(delta, 0, span) * dil)
    bias = jnp.transpose(rel_bias[bucket], (2, 0, 1)).astype(jnp.float32)
    valid = (delta >= 0) & (delta <= span)
    has_prev = (jnp.arange(nb)[:, None, None] > 0) | (j >= BLK)[None]
    mask = valid[None] & has_prev

    s = jnp.where(mask[None, :, None, None], s + bias, -1e30)
    m = jnp.max(s, axis=-1, keepdims=True)
    p = jnp.exp(s - m)
    l = jnp.sum(p, axis=-1, keepdims=True)
    o = jnp.einsum('bnrhij,bnjrhd->bnirhd', (p / l).astype(v.dtype), vv)
    lse = (m + jnp.log(l))[..., 0]
    lse = jnp.transpose(lse, (0, 1, 4, 2, 3)).reshape(Bsz, S_pad, H)[:, :S]
    o = o.reshape(Bsz, S_pad, H, hd)[:, :S]
    return o, lse


def dilated_attention(q, k, v, rel_bias):
    outs, lses = [], []
    for window, dil in DILATIONS:
        o, lse = dilated_group(q, k, v, rel_bias, window, dil)
        outs.append(o)
        lses.append(lse)
    w = jax.nn.softmax(jnp.stack(lses, axis=0), axis=0)
    return jnp.einsum('gbsh,gbshd->bshd', w.astype(q.dtype), jnp.stack(outs, axis=0))


def linear_combine(e1, e2):
    a1, b1 = e1
    a2, b2 = e2
    return a1 * a2, a2 * b1 + b2


def complex_combine(e1, e2):
    ar1, ai1, br1, bi1 = e1
    ar2, ai2, br2, bi2 = e2
    return (ar2 * ar1 - ai2 * ai1,
            ar2 * ai1 + ai2 * ar1,
            ar2 * br1 - ai2 * bi1 + br2,
            ar2 * bi1 + ai2 * br1 + bi2)


def rglru_branch(xb, conv_w, conv_b, wa, ba, wx, bx, lam):
    Bsz, S, _ = xb.shape
    xc = causal_dwconv(xb, conv_w) + conv_b
    xh = xc.reshape(Bsz, S, LRU_HEADS, LRU_HEAD_DIM)
    r = jax.nn.sigmoid(jnp.einsum('bshi,hij->bshj', xh, wa).reshape(Bsz, S, BR) + ba)
    ig = jax.nn.sigmoid(jnp.einsum('bshi,hij->bshj', xh, wx).reshape(Bsz, S, BR) + bx)
    log_a = -LRU_C * r * jax.nn.softplus(-lam)
    a = jnp.exp(log_a)
    mult = jnp.sqrt(-jnp.expm1(2.0 * log_a))
    _, h = lax.associative_scan(linear_combine, (a, mult * ig * xc), axis=1)
    return h


def s5_branch(u, lam_re, lam_im, log_dt, b_re, b_im, c_re, c_im, d_skip, w_glu, b_glu):
    Bsz, S, _ = u.shape
    ug = u.reshape(Bsz, S, S5_GROUPS, S5_CH)
    dt = jnp.exp(log_dt)[:, None]
    mag = jnp.exp(lam_re * dt)
    ab_re = mag * jnp.cos(lam_im * dt)
    ab_im = mag * jnp.sin(lam_im * dt)
    den = lam_re * lam_re + lam_im * lam_im
    f_re = ((ab_re - 1.0) * lam_re + ab_im * lam_im) / den
    f_im = (ab_im * lam_re - (ab_re - 1.0) * lam_im) / den
    bb_re = f_re[..., None] * b_re - f_im[..., None] * b_im
    bb_im = f_re[..., None] * b_im + f_im[..., None] * b_re
    bu_re = jnp.einsum('bsgc,gpc->bsgp', ug, bb_re)
    bu_im = jnp.einsum('bsgc,gpc->bsgp', ug, bb_im)
    a_re = jnp.broadcast_to(ab_re, bu_re.shape)
    a_im = jnp.broadcast_to(ab_im, bu_im.shape)
    _, _, x_re, x_im = lax.associative_scan(complex_combine, (a_re, a_im, bu_re, bu_im), axis=1)
    y = jnp.einsum('gcp,bsgp->bsgc', c_re, x_re) - jnp.einsum('gcp,bsgp->bsgc', c_im, x_im)
    y = y.reshape(Bsz, S, BR) + d_skip * u
    y = jax.nn.gelu(y)
    return y * jax.nn.sigmoid(y @ w_glu + b_glu)


def setup_inputs(seed: int = 0) -> dict:
    key = jax.random.key(seed)
    ks = jax.random.split(key, 32)

    def nrm(k, shape, scale):
        return scale * jax.random.normal(k, shape, jnp.float32)

    HD = LRU_HEAD_DIM
    a_c = jax.random.uniform(ks[13], (DEPTH, BR), jnp.float32, minval=0.9, maxval=0.999)
    a0 = a_c ** (1.0 / LRU_C)
    lru_lambda = jnp.log(a0) - jnp.log1p(-a0)
    n_idx = jnp.arange(S5_STATE, dtype=jnp.float32)
    return {
        "x": nrm(ks[0], (BATCH, SEQ, D_MODEL), 1.0),
        "c": nrm(ks[1], (BATCH, D_MODEL), 1.0),
        "rel_bias": nrm(ks[2], (REL_BUCKETS, ATT_HEADS), 0.5),
        "w_ada": nrm(ks[3], (DEPTH, D_MODEL, 3 * D_MODEL), 0.1 * D_MODEL ** -0.5),
        "b_ada": nrm(ks[4], (DEPTH, 3 * D_MODEL), 0.01),
        "w_in": nrm(ks[5], (DEPTH, D_MODEL, N_IN), D_MODEL ** -0.5),
        "conv_a": nrm(ks[6], (DEPTH, CONV_A_WIDTH, BR), CONV_A_WIDTH ** -0.5),
        "conv_c": nrm(ks[7], (DEPTH, CONV_C_WIDTH, BR), CONV_C_WIDTH ** -0.5),
        "conv_c_b": nrm(ks[8], (DEPTH, BR), 0.01),
        "lru_wa": nrm(ks[9], (DEPTH, LRU_HEADS, HD, HD), HD ** -0.5),
        "lru_ba": nrm(ks[10], (DEPTH, BR), 0.01),
        "lru_wx": nrm(ks[11], (DEPTH, LRU_HEADS, HD, HD), HD ** -0.5),
        "lru_bx": nrm(ks[12], (DEPTH, BR), 0.01),
        "lru_lambda": lru_lambda,
        "s5_lam_re": -0.5 + nrm(ks[14], (DEPTH, S5_GROUPS, S5_STATE), 0.01),
        "s5_lam_im": jnp.pi * n_idx + nrm(ks[15], (DEPTH, S5_GROUPS, S5_STATE), 0.01),
        "s5_log_dt": jax.random.uniform(ks[16], (DEPTH, S5_GROUPS), jnp.float32,
                                        minval=math.log(1e-3), maxval=math.log(1e-1)),
        "s5_b_re": nrm(ks[17], (DEPTH, S5_GROUPS, S5_STATE, S5_CH), (2 * S5_CH) ** -0.5),
        "s5_b_im": nrm(ks[18], (DEPTH, S5_GROUPS, S5_STATE, S5_CH), (2 * S5_CH) ** -0.5),
        "s5_c_re": nrm(ks[19], (DEPTH, S5_GROUPS, S5_CH, S5_STATE), (2 * S5_STATE) ** -0.5),
        "s5_c_im": nrm(ks[20], (DEPTH, S5_GROUPS, S5_CH, S5_STATE), (2 * S5_STATE) ** -0.5),
        "s5_d": nrm(ks[21], (DEPTH, BR), 1.0),
        "s5_w_glu": nrm(ks[22], (DEPTH, BR, BR), BR ** -0.5),
        "s5_b_glu": nrm(ks[23], (DEPTH, BR), 0.01),
        "w_out": nrm(ks[24], (DEPTH, D_MIX, D_MODEL), BETA * D_MIX ** -0.5),
        "ln_g": 1.0 + nrm(ks[25], (DEPTH, D_MODEL), 0.01),
        "ln_b": nrm(ks[26], (DEPTH, D_MODEL), 0.01),
    }


def reference(x, c, rel_bias, w_ada, b_ada, w_in, conv_a, conv_c, conv_c_b, lru_wa, lru_ba,
              lru_wx, lru_bx, lru_lambda, s5_lam_re, s5_lam_im, s5_log_dt, s5_b_re, s5_b_im,
              s5_c_re, s5_c_im, s5_d, s5_w_glu, s5_b_glu, w_out, ln_g, ln_b):
    Bsz, S, _ = x.shape
    cond = jax.nn.silu(c)
    for l in range(DEPTH):
        ada = cond @ w_ada[l] + b_ada[l]
        shift, scale, gate = jnp.split(ada, 3, axis=-1)
        h = x * (1.0 + scale[:, None]) + shift[:, None]
        proj = h @ w_in[l]
        pa, pb, pc, pd = jnp.split(proj, [4 * BR, 8 * BR, 10 * BR], axis=-1)

        a_b, a_c, a_x, a_g = jnp.split(pa, 4, axis=-1)
        y_a = a_b * causal_dwconv(a_c * a_x, conv_a[l]) * jax.nn.silu(a_g)

        q, k, v, b_g = jnp.split(pb, 4, axis=-1)
        q = q.reshape(Bsz, S, ATT_HEADS, ATT_HEAD_DIM) * (ATT_HEAD_DIM ** -0.5)
        k = k.reshape(Bsz, S, ATT_HEADS, ATT_HEAD_DIM)
        v = v.reshape(Bsz, S, ATT_HEADS, ATT_HEAD_DIM)
        y_b = dilated_attention(q, k, v, rel_bias).reshape(Bsz, S, BR) * jax.nn.silu(b_g)

        c_x, c_g = jnp.split(pc, 2, axis=-1)
        y_c = rglru_branch(c_x, conv_c[l], conv_c_b[l], lru_wa[l], lru_ba[l], lru_wx[l],
                           lru_bx[l], lru_lambda[l]) * jax.nn.silu(c_g)

        d_u, d_g = jnp.split(pd, 2, axis=-1)
        y_d = s5_branch(d_u, s5_lam_re[l], s5_lam_im[l], s5_log_dt[l], s5_b_re[l], s5_b_im[l],
                        s5_c_re[l], s5_c_im[l], s5_d[l], s5_w_glu[l], s5_b_glu[l]) * jax.nn.silu(d_g)

        y = jnp.concatenate([y_a, y_b, y_c, y_d], axis=-1) @ w_out[l]
        x = layer_norm(ALPHA * x + (1.0 + gate[:, None]) * y, ln_g[l], ln_b[l])
    return x
```

```cpp
#include <hip/hip_runtime.h>
#include <cstdio>
#include <cstdint>
namespace pg8 {
#define PG8_LAS __attribute__((address_space(3)))
typedef unsigned short bf16_t;
typedef short bf16x8 __attribute__((ext_vector_type(8)));
typedef float f32x4 __attribute__((ext_vector_type(4)));
typedef unsigned u32x4 __attribute__((ext_vector_type(4)));
constexpr int BM = 256, BK = 64, HALF = 128, HTB = HALF * BK * 2  , STAGE_BYTES = 8 * HTB, NXCD = 8, WGM = 8;

__host__ __device__ __forceinline__ int lds_byte(int r, int c) { const int st = (r >> 4) * 2 + (c >> 5), rr = r & 15, cc = c & 31, ob = rr * 64 + cc * 2; return st * 1024 + (ob ^ (((ob >> 9) & 1) << 5)); }
__host__ __device__ __forceinline__ void stage_rc(int b, int& R, int& C) { const int st = b / 1024, sb = b % 1024, swz = sb ^ (((sb >> 9) & 1) << 5); R = (st >> 1) * 16 + swz / 64; C = (st & 1) * 32 + (swz % 64) / 2; }
__host__ __device__ __forceinline__ int perm32(int rho) { const int n = rho >> 4, i = rho & 15; return 8 * (i >> 2) + 4 * n + (i & 3); }

struct Unit { int pm, pn; };
struct Gemm { const bf16_t* A; const bf16_t* Bt; int M, N, K; };

struct StaticOrder {
    int nM, nN, nwg, G, c;
    __host__ __device__ void init(int M, int N, int G_, int c_) { nM = M / BM; nN = N / BM; nwg = nM * nN; G = G_; c = c_; }
    __host__ __device__ bool next(int i, Unit& u) const {
        const long L = (long)i * G + c; if (L >= nwg) return false;
        int wgid = (int)L; { const int q = nwg / NXCD, r = nwg % NXCD, xcd = wgid % NXCD, off = wgid / NXCD; wgid = (xcd < r ? xcd * (q + 1) : r * (q + 1) + (xcd - r) * q) + off; }
        const int nig = WGM * nN, gid = wgid / nig, fm = gid * WGM, gsz = (nM - fm) < WGM ? (nM - fm) : WGM;
        u.pm = fm + ((wgid % nig) % gsz); u.pn = (wgid % nig) / gsz; return true;
    }
    __device__ __forceinline__ void a_ready(const Unit&) const {}
    __device__ __forceinline__ void done(const Unit&) const {}
};

__device__ __forceinline__ unsigned cvt_pk_bf16(float lo, float hi) { unsigned r; asm volatile("v_cvt_pk_bf16_f32 %0, %1, %2" : "=v"(r) : "v"(lo), "v"(hi)); return r; }
typedef float f32x2 __attribute__((ext_vector_type(2)));

__device__ __forceinline__ float silu_f(float v) { return v * __builtin_amdgcn_rcpf(1.0f + __expf(-v)); }
__device__ __forceinline__ float sigm_f(float v) { return __builtin_amdgcn_rcpf(1.0f + __expf(-v)); }
__device__ __forceinline__ float bflo(unsigned w) { return __uint_as_float(w << 16); }
__device__ __forceinline__ float bfhi(unsigned w) { return __uint_as_float(w & 0xffff0000u); }

struct EpiProj {
    static constexpr bool PERM = true, AFTER_DRAIN = false;
    bf16_t* O; int ldc;
    __device__ __forceinline__ void operator()(const f32x4 (&acc)[2][2][4][2], const Unit& u, int wr, int wc, int fr, int fq) const {
        const int row0 = u.pm * BM + wr * 64 + fr, col0 = u.pn * BM + wc * 32 + 8 * fq;
        const int pn = u.pn; const bool gate = (pn == 6) | (pn == 7) | (pn == 14) | (pn == 15) | (pn == 18) | (pn == 19) | (pn == 22) | (pn == 23);
#pragma unroll
        for (int ai = 0; ai < 2; ++ai)
#pragma unroll
            for (int m = 0; m < 4; ++m) { bf16_t* rowp = O + (size_t)(row0 + ai * HALF + m * 16) * ldc + col0;
#pragma unroll
                for (int bj = 0; bj < 2; ++bj) { f32x4 v0 = acc[ai][bj][m][0], v1 = acc[ai][bj][m][1];
                    if (gate) {
#pragma unroll
                        for (int j = 0; j < 4; ++j) { v0[j] = silu_f(v0[j]); v1[j] = silu_f(v1[j]); } }
                    u32x4 w; w.x = cvt_pk_bf16(v0[0], v0[1]); w.y = cvt_pk_bf16(v0[2], v0[3]); w.z = cvt_pk_bf16(v1[0], v1[1]); w.w = cvt_pk_bf16(v1[2], v1[3]);
                    *(u32x4*)(rowp + bj * HALF) = w; } }
    }
};
struct EpiGlu {
    static constexpr bool PERM = true, AFTER_DRAIN = false;
    bf16_t* O; int ldo; const bf16_t* Y; int ldy; const bf16_t* G; int ldg; const float* bias;
    __device__ __forceinline__ void operator()(const f32x4 (&acc)[2][2][4][2], const Unit& u, int wr, int wc, int fr, int fq) const {
        const int row0 = u.pm * BM + wr * 64 + fr, col0 = u.pn * BM + wc * 32 + 8 * fq;
        f32x4 bv[2][2];
#pragma unroll
        for (int bj = 0; bj < 2; ++bj)
#pragma unroll
            for (int n = 0; n < 2; ++n) bv[bj][n] = *(const f32x4*)(bias + col0 + bj * HALF + 4 * n);
#pragma unroll
        for (int ai = 0; ai < 2; ++ai)
#pragma unroll
            for (int m = 0; m < 4; ++m) { const size_t row = (size_t)(row0 + ai * HALF + m * 16);
#pragma unroll
                for (int bj = 0; bj < 2; ++bj) { const int col = col0 + bj * HALF;
                    const u32x4 yv = *(const u32x4*)(Y + row * ldy + col), gv = *(const u32x4*)(G + row * ldg + col);
                    const f32x4 v0 = acc[ai][bj][m][0] + bv[bj][0], v1 = acc[ai][bj][m][1] + bv[bj][1];
                    u32x4 w;
                    w.x = cvt_pk_bf16(bflo(yv.x) * sigm_f(v0[0]) * bflo(gv.x), bfhi(yv.x) * sigm_f(v0[1]) * bfhi(gv.x));
                    w.y = cvt_pk_bf16(bflo(yv.y) * sigm_f(v0[2]) * bflo(gv.y), bfhi(yv.y) * sigm_f(v0[3]) * bfhi(gv.y));
                    w.z = cvt_pk_bf16(bflo(yv.z) * sigm_f(v1[0]) * bflo(gv.z), bfhi(yv.z) * sigm_f(v1[1]) * bfhi(gv.z));
                    w.w = cvt_pk_bf16(bflo(yv.w) * sigm_f(v1[2]) * bflo(gv.w), bfhi(yv.w) * sigm_f(v1[3]) * bfhi(gv.w));
                    *(u32x4*)(O + row * ldo + col) = w; } }
    }
};
struct EpiRes {
    static constexpr bool PERM = false, AFTER_DRAIN = false;
    const float* X; float* Z; int ldc; const float* gate; float alpha;
    __device__ __forceinline__ void operator()(const f32x4 (&acc)[2][2][4][2], const Unit& u, int wr, int wc, int fr, int fq) const {
        const int row0 = u.pm * BM + wr * 64 + fr, col0 = u.pn * BM + wc * 32 + 4 * fq;
        f32x4 gv[2][2];
#pragma unroll
        for (int bj = 0; bj < 2; ++bj)
#pragma unroll
            for (int n = 0; n < 2; ++n) gv[bj][n] = *(const f32x4*)(gate + col0 + bj * HALF + n * 16) + 1.0f;
#pragma unroll
        for (int ai = 0; ai < 2; ++ai)
#pragma unroll
            for (int m = 0; m < 4; ++m) { const size_t off = (size_t)(row0 + ai * HALF + m * 16) * ldc + col0;
#pragma unroll
                for (int bj = 0; bj < 2; ++bj)
#pragma unroll
                    for (int n = 0; n < 2; ++n) { const f32x4 xv = *(const f32x4*)(X + off + bj * HALF + n * 16);
                        *(f32x4*)(Z + off + bj * HALF + n * 16) = xv * alpha + gv[bj][n] * acc[ai][bj][m][n]; } }
    }
};

template <class Epi, class Sched, bool ALIGN_EPI = false, bool SP2 = false>
__device__ __forceinline__ void gemm_phase(PG8_LAS unsigned char* lds, const Gemm g, const Sched& S, const Epi& E) {
    int tid_ = threadIdx.x; asm volatile("" : "+v"(tid_));
    const int tid = tid_, wid = __builtin_amdgcn_readfirstlane(tid >> 6), lane = tid & 63, wr = wid >> 2, wc = wid & 3, fr = lane & 15, fq = lane >> 4;
    const int K = g.K, nt = K / BK;
    unsigned voffA[2], voffB[2];
#pragma unroll
    for (int i = 0; i < 2; ++i) { int R, C; stage_rc(tid * 16 + i * 8192, R, C); const int Rb = Epi::PERM ? ((R & ~31) + perm32(R & 31)) : R;
        voffA[i] = (unsigned)(R * K + C) * 2u; voffB[i] = (unsigned)(Rb * K + C) * 2u; }
    const size_t kstep = (size_t)(BK * 2);
    const size_t hstep = (size_t)HALF * K * 2;
    const size_t tstep = 2 * hstep;
    const unsigned ldsw = (unsigned)wid * 1024u;
    const int aoff = lds_byte(wr * 64 + fr, fq * 8), boff = lds_byte(wc * 32 + fr, fq * 8);
#define PG8_SA(b, h) (((b) * 2 + (h)) * HTB)
#define PG8_SB(b, h) ((4 + (b) * 2 + (h)) * HTB)
#define PG8_STAGE(bufoff, gbase, voff) do { _Pragma("unroll") for (int _i = 0; _i < 2; ++_i) \
        __builtin_amdgcn_global_load_lds((const unsigned*)((const char*)(gbase) + (voff)[_i]), (PG8_LAS unsigned*)(lds + (bufoff) + ldsw + _i * 8192), 16, 0, 0); } while (0)
#define PG8_LDA(dst, b, h) do { _Pragma("unroll") for (int m = 0; m < 4; ++m) _Pragma("unroll") for (int k = 0; k < 2; ++k) dst[m][k] = *(const PG8_LAS bf16x8*)(lds + PG8_SA(b, h) + aoff + m * 2048 + k * 1024); } while (0)
#define PG8_LDB(dst, b, h) do { _Pragma("unroll") for (int n = 0; n < 2; ++n) _Pragma("unroll") for (int k = 0; k < 2; ++k) dst[n][k] = *(const PG8_LAS bf16x8*)(lds + PG8_SB(b, h) + boff + n * 2048 + k * 1024); } while (0)
#define PG8_MMA(ai, bj, At, Bt) do { __builtin_amdgcn_s_setprio(1); _Pragma("unroll") for (int m = 0; m < 4; ++m) _Pragma("unroll") for (int n = 0; n < 2; ++n) _Pragma("unroll") for (int k = 0; k < 2; ++k) \
        acc[ai][bj][m][n] = __builtin_amdgcn_mfma_f32_16x16x32_bf16(Bt[n][k], At[m][k], acc[ai][bj][m][n], 0, 0, 0); __builtin_amdgcn_s_setprio(0); } while (0)
#define PG8_WAIT_V(n) asm volatile("s_waitcnt vmcnt(" #n ")" ::: "memory")
#define PG8_WAIT_L(n) asm volatile("s_waitcnt lgkmcnt(" #n ")" ::: "memory")
#define PG8_BAR __builtin_amdgcn_s_barrier()
#define PG8_SCHED __builtin_amdgcn_sched_barrier(0)
    Unit cur, nxt; int ui = 0;
    if (!S.next(0, cur)) return;
    f32x4 acc[2][2][4][2];
#pragma unroll
    for (int a = 0; a < 2; ++a)
#pragma unroll
        for (int b = 0; b < 2; ++b)
#pragma unroll
            for (int m = 0; m < 4; ++m)
#pragma unroll
                for (int n = 0; n < 2; ++n) acc[a][b][m][n] = (f32x4){0.f, 0.f, 0.f, 0.f};
    bf16x8 At[4][2], B0[2][2], B1[2][2];
    const char* cA = (const char*)g.A + (size_t)cur.pm * tstep; const char* cB = (const char*)g.Bt + (size_t)cur.pn * tstep;
    S.a_ready(cur);
    if constexpr (SP2) {
        PG8_STAGE(PG8_SB(0, 0), cB, voffB); PG8_STAGE(PG8_SB(0, 1), cB + hstep, voffB); PG8_STAGE(PG8_SA(0, 0), cA, voffA); PG8_STAGE(PG8_SA(0, 1), cA + hstep, voffA);
        if (wr == 1) PG8_BAR;
        PG8_WAIT_V(2); PG8_BAR;
        PG8_STAGE(PG8_SB(1, 0), cB + kstep, voffB); PG8_STAGE(PG8_SA(1, 0), cA + kstep, voffA); PG8_STAGE(PG8_SB(1, 1), cB + hstep + kstep, voffB);
        PG8_WAIT_V(6); PG8_BAR;
    } else {
        PG8_STAGE(PG8_SB(0, 0), cB, voffB); PG8_STAGE(PG8_SA(0, 0), cA, voffA); PG8_STAGE(PG8_SB(0, 1), cB + hstep, voffB); PG8_STAGE(PG8_SA(0, 1), cA + hstep, voffA);
        if (wr == 1) PG8_BAR;
        PG8_WAIT_V(4); PG8_BAR;
        PG8_STAGE(PG8_SB(1, 0), cB + kstep, voffB); PG8_STAGE(PG8_SA(1, 0), cA + kstep, voffA); PG8_STAGE(PG8_SB(1, 1), cB + hstep + kstep, voffB);
        PG8_WAIT_V(6); PG8_BAR;
    }
    for (;;) {
        const bool has_next = S.next(ui + 1, nxt);
        const char* nA = has_next ? (const char*)g.A + (size_t)nxt.pm * tstep : cA; const char* nB = has_next ? (const char*)g.Bt + (size_t)nxt.pn * tstep : cB;
        for (int t = 0; t < nt; t += 2) {
            const bool last = (t == nt - 2);
            const char* a1 = cA + (size_t)(t + 1) * kstep;
            const char* a2 = last ? nA : cA + (size_t)(t + 2) * kstep; const char* b2 = last ? nB : cB + (size_t)(t + 2) * kstep;
            const char* a3 = a2 + kstep; const char* b3 = b2 + kstep;
            if (last && has_next) S.a_ready(nxt);
            if constexpr (SP2) {
            PG8_LDB(B0, 0, 0); PG8_LDB(B1, 0, 1); PG8_SCHED; PG8_LDA(At, 0, 0); PG8_STAGE(PG8_SA(1, 1), a1 + hstep, voffA);
            PG8_WAIT_V(8); PG8_WAIT_L(0); PG8_BAR; PG8_MMA(0, 0, At, B0); PG8_MMA(0, 1, At, B1); PG8_BAR; PG8_SCHED;
            PG8_LDA(At, 0, 1); PG8_STAGE(PG8_SB(0, 0), b2, voffB); PG8_STAGE(PG8_SB(0, 1), b2 + hstep, voffB); PG8_STAGE(PG8_SA(0, 0), a2, voffA);
            PG8_WAIT_V(8); PG8_WAIT_L(0); PG8_BAR; PG8_MMA(1, 0, At, B0); PG8_MMA(1, 1, At, B1); PG8_BAR; PG8_SCHED;
            PG8_LDB(B0, 1, 0); PG8_LDB(B1, 1, 1); PG8_SCHED; PG8_LDA(At, 1, 0); PG8_STAGE(PG8_SA(0, 1), a2 + hstep, voffA);
            PG8_WAIT_V(8); PG8_WAIT_L(0); PG8_BAR; PG8_MMA(0, 0, At, B0); PG8_MMA(0, 1, At, B1); PG8_BAR; PG8_SCHED;
            PG8_LDA(At, 1, 1); PG8_STAGE(PG8_SB(1, 0), b3, voffB); PG8_STAGE(PG8_SB(1, 1), b3 + hstep, voffB); PG8_STAGE(PG8_SA(1, 0), a3, voffA);
            PG8_WAIT_V(8); PG8_WAIT_L(0); PG8_BAR; PG8_MMA(1, 0, At, B0); PG8_MMA(1, 1, At, B1); PG8_BAR; PG8_SCHED;
            } else {
            PG8_LDB(B0, 0, 0); PG8_SCHED; PG8_LDA(At, 0, 0); PG8_STAGE(PG8_SA(1, 1), a1 + hstep, voffA);
            PG8_WAIT_L(8); PG8_BAR; PG8_WAIT_L(0); PG8_MMA(0, 0, At, B0); PG8_BAR; PG8_SCHED;
            PG8_LDB(B1, 0, 1); PG8_STAGE(PG8_SB(0, 0), b2, voffB);
            PG8_BAR; PG8_WAIT_L(0); PG8_MMA(0, 1, At, B1); PG8_BAR;
            PG8_LDA(At, 0, 1); PG8_STAGE(PG8_SA(0, 0), a2, voffA);
            PG8_BAR; PG8_WAIT_L(0); PG8_MMA(1, 0, At, B0); PG8_BAR; PG8_SCHED;
            PG8_STAGE(PG8_SB(0, 1), b2 + hstep, voffB);
            PG8_WAIT_V(6); PG8_BAR; PG8_MMA(1, 1, At, B1); PG8_BAR;
            PG8_LDB(B0, 1, 0); PG8_SCHED; PG8_LDA(At, 1, 0); PG8_STAGE(PG8_SA(0, 1), a2 + hstep, voffA);
            PG8_WAIT_L(8); PG8_BAR; PG8_WAIT_L(0); PG8_MMA(0, 0, At, B0); PG8_BAR; PG8_SCHED;
            PG8_LDB(B1, 1, 1); PG8_STAGE(PG8_SB(1, 0), b3, voffB);
            PG8_BAR; PG8_WAIT_L(0); PG8_MMA(0, 1, At, B1); PG8_BAR;
            PG8_LDA(At, 1, 1); PG8_STAGE(PG8_SA(1, 0), a3, voffA);
            PG8_BAR; PG8_WAIT_L(0); PG8_MMA(1, 0, At, B0); PG8_BAR; PG8_SCHED;
            PG8_STAGE(PG8_SB(1, 1), b3 + hstep, voffB);
            PG8_WAIT_V(6); PG8_BAR; PG8_MMA(1, 1, At, B1); PG8_BAR;
            }
        }
        if constexpr (ALIGN_EPI) { if (wr == 0) PG8_BAR; }
        if constexpr (!Epi::AFTER_DRAIN) { E(acc, cur, wr, wc, fr, fq); S.done(cur); }
        if (!has_next) break;
#pragma unroll
        for (int a = 0; a < 2; ++a)
#pragma unroll
            for (int b = 0; b < 2; ++b)
#pragma unroll
                for (int m = 0; m < 4; ++m)
#pragma unroll
                    for (int n = 0; n < 2; ++n) acc[a][b][m][n] = (f32x4){0.f, 0.f, 0.f, 0.f};
        cur = nxt; cA = nA; cB = nB; ++ui;
        if constexpr (ALIGN_EPI) { if (wr == 1) PG8_BAR; }
    }
    PG8_WAIT_V(0);
    if constexpr (!ALIGN_EPI) { if (wr == 0) PG8_BAR; }
    PG8_BAR;
    if constexpr (Epi::AFTER_DRAIN) { E.fused(acc, cur, wr, wc, fr, fq, lds, wid, lane); S.done(cur); }
#undef PG8_SA
#undef PG8_SB
#undef PG8_STAGE
#undef PG8_LDA
#undef PG8_LDB
#undef PG8_MMA
#undef PG8_WAIT_V
#undef PG8_WAIT_L
#undef PG8_BAR
#undef PG8_SCHED
}
}

#ifndef MK_FUSED
#define MK_FUSED 0
#endif
#define GAS __attribute__((address_space(1)))
#define LAS __attribute__((address_space(3)))
typedef unsigned short bf16;
typedef unsigned v4u __attribute__((ext_vector_type(4)));
typedef unsigned v2u __attribute__((ext_vector_type(2)));
typedef float f32x4 __attribute__((ext_vector_type(4)));
typedef float f32x2 __attribute__((ext_vector_type(2)));
typedef float f32x16 __attribute__((ext_vector_type(16)));
typedef short bf16x8 __attribute__((ext_vector_type(8)));
typedef short s16x4 __attribute__((ext_vector_type(4)));
typedef GAS unsigned gu32;

constexpr int NWAVES = 8, NTHR = 512;
constexpr int SEQ = 8192, DM = 2048, NIN = 6144, BR = 512, DEPTH = 2;
constexpr int COL_AB = 0, COL_AC = 512, COL_AX = 1024, COL_AG = 1536, COL_Q = 2048, COL_K = 2560, COL_V = 3072, COL_BG = 3584, COL_CX = 4096, COL_CG = 4608, COL_DU = 5120, COL_DG = 5632;
constexpr float LN_EPS = 1e-5f;
constexpr float ALPHA = 1.41421356237309515f;
constexpr int LRU_LC = 64, LRU_NC = SEQ / LRU_LC;
constexpr int S5_LC = 128, S5_NC = SEQ / S5_LC;
constexpr int ADA_KC = 32;
constexpr size_t MiB = 1u << 20;
constexpr size_t WS_CTL = 0, CTL_ZERO_BYTES = 65536;
constexpr size_t WS_WIN = 2 * MiB;
constexpr size_t WS_WOUT = 50 * MiB;
constexpr size_t WS_WGLU = 66 * MiB;
constexpr size_t WS_LRUW = 67 * MiB;
constexpr size_t WS_S5P = 68 * MiB;
constexpr size_t S5P_LAM1 = 0, S5P_LAML = 16384, S5P_BBT = 65536, S5P_CMT = 262144, S5P_SP8 = 524288, S5P_STRIDE = MiB;
constexpr size_t WS_ADAP = 70 * MiB;
constexpr size_t WS_ADAF = 72 * MiB;
constexpr size_t WS_H = 74 * MiB;
constexpr size_t WS_PROJ = 106 * MiB;
constexpr size_t WS_OG = 202 * MiB;
constexpr size_t WS_LSE = 226 * MiB;
constexpr size_t WS_YG = 227 * MiB;
constexpr size_t WS_LRUC = 235 * MiB;
constexpr size_t WS_S5C = 236 * MiB;
constexpr size_t WS_END = 237 * MiB;
constexpr int CW_BAR = 1024;
constexpr int RING_BYTES = 131072, LDSCTL_OFF = RING_BYTES, MISC_OFF = LDSCTL_OFF + 320, LDS_BYTES = 147456;

#define RLX_AGENT __ATOMIC_RELAXED, __HIP_MEMORY_SCOPE_AGENT
#define LDS_WAIT() asm volatile("s_waitcnt lgkmcnt(0)" ::: "memory")
__device__ __forceinline__ unsigned f2bf(float f) { unsigned u = __builtin_bit_cast(unsigned, f); return (u + 0x7fffu + ((u >> 16) & 1u)) >> 16; }
__device__ __forceinline__ unsigned pk2(float lo, float hi) { return f2bf(lo) | (f2bf(hi) << 16); }
__device__ __forceinline__ float bf2f(unsigned short b) { return __uint_as_float(((unsigned)b) << 16); }
__device__ __forceinline__ float bflo(unsigned w) { return __uint_as_float(w << 16); }
__device__ __forceinline__ float bfhi(unsigned w) { return __uint_as_float(w & 0xffff0000u); }
__device__ __forceinline__ float sigm(float v) { return __builtin_amdgcn_rcpf(1.0f + __expf(-v)); }

#define XB_TMO      128
#define XB_XCNT(j)  (256  + 64 * (j))
#define XB_XSUB(j)  (1280 + 64 * (j))
#define XB_XGEN(j)  (2304 + 64 * (j))
#define XB_TOP      3328
#define XB_TOPGEN   3392
#define XCD_BAR_WORDS 3456
#define XB_SPIN_CAP (1u << 22)
__device__ __forceinline__ unsigned xb_ld(unsigned* p)              { return __hip_atomic_load(p, __ATOMIC_RELAXED, __HIP_MEMORY_SCOPE_AGENT); }
__device__ __forceinline__ unsigned xb_add(unsigned* p, unsigned v) { return __hip_atomic_fetch_add(p, v, __ATOMIC_RELAXED, __HIP_MEMORY_SCOPE_AGENT); }
__device__ __forceinline__ unsigned xb_xcc_id() { return (unsigned)__builtin_amdgcn_s_getreg((3 << 11) | 20) & 0xFu; }
#define XB_SPIN(cond, bar) do { unsigned _sp = 0; while (cond) { __builtin_amdgcn_s_sleep(1); \
    if ((++_sp & 255u) == 0u) { if (xb_ld(&(bar)[XB_TMO])) break; if (_sp > XB_SPIN_CAP) { atomicAdd(&(bar)[XB_TMO], 1u); break; } } } } while (0)
struct XcdBarrier { unsigned* bar; unsigned x; volatile LAS unsigned* st; };
__device__ __forceinline__ XcdBarrier xcd_barrier_post(unsigned* bar, volatile LAS unsigned* st) {
    XcdBarrier b; b.bar = bar; b.x = xb_xcc_id(); b.st = st;
    if (threadIdx.x == 0) (void)xb_add(&bar[XB_XCNT(b.x)], 1u);
    return b;
}
__device__ __forceinline__ void xcd_barrier_complete(unsigned* bar, unsigned x, unsigned& nloc, unsigned& nx) {
    const unsigned G = gridDim.x * gridDim.y * gridDim.z;
    unsigned sum, cnt, mine, sp = 0u;
    for (;;) {
        sum = 0u; cnt = 0u; mine = 0u;
#pragma unroll
        for (unsigned j = 0; j < 16; ++j) { const unsigned c = xb_ld(&bar[XB_XCNT(j)]); sum += c; cnt += (c > 0u) ? 1u : 0u; mine = (j == x) ? c : mine; }
        if (sum == G) break;
        __builtin_amdgcn_s_sleep(1);
        if ((++sp & 255u) == 0u) { if (xb_ld(&bar[XB_TMO])) break; if (sp > XB_SPIN_CAP) { atomicAdd(&bar[XB_TMO], 1u); break; } }
    }
    nloc = mine > 0u ? mine : 1u; nx = cnt > 0u ? cnt : 1u;
}
__device__ __forceinline__ void xcd_barrier(const XcdBarrier& b) {
    asm volatile("s_waitcnt vmcnt(0)" ::: "memory");
    __syncthreads();
    if (threadIdx.x == 0) {
        unsigned* bar = b.bar;
        __builtin_amdgcn_s_waitcnt(0);
        unsigned nloc = b.st[0], nx = b.st[1];
        if (nloc == 0u) { xcd_barrier_complete(bar, b.x, nloc, nx); b.st[0] = nloc; b.st[1] = nx; }
        const unsigned old = xb_add(&bar[XB_XSUB(b.x)], 1u);
        const unsigned gen = old / nloc;
        if (old + 1u == (gen + 1u) * nloc) {
            __builtin_amdgcn_fence(__ATOMIC_RELEASE, "agent");
            asm volatile("s_waitcnt vmcnt(0)" ::: "memory");
            const unsigned og = xb_add(&bar[XB_TOP], 1u);
            const unsigned tg = og / nx;
            if (og + 1u == (tg + 1u) * nx) xb_add(&bar[XB_TOPGEN], 1u);
            else XB_SPIN(xb_ld(&bar[XB_TOPGEN]) == tg, bar);
            __builtin_amdgcn_fence(__ATOMIC_ACQUIRE, "agent");
            xb_add(&bar[XB_XGEN(b.x)], 1u);
            asm volatile("s_waitcnt vmcnt(0)" ::: "memory");
        } else {
            XB_SPIN(xb_ld(&bar[XB_XGEN(b.x)]) == gen, bar);
            __builtin_amdgcn_fence(__ATOMIC_ACQUIRE, "agent");
            asm volatile("s_waitcnt vmcnt(0)" ::: "memory");
        }
    }
    __syncthreads();
}

struct Params { const float* in[27]; float* out; unsigned char* ws; int ph_lo, ph_hi; };
enum { I_X = 0, I_C, I_RELB, I_WADA, I_BADA, I_WIN, I_CONVA, I_CONVC, I_CONVCB, I_LRUWA, I_LRUBA, I_LRUWX, I_LRUBX, I_LRULAM, I_S5LRE, I_S5LIM, I_S5LDT, I_S5BRE, I_S5BIM,
       I_S5CRE, I_S5CIM, I_S5D, I_S5WGLU, I_S5BGLU, I_WOUT, I_LNG, I_LNB };

__device__ __forceinline__ void p0_ada_item(const float* c, const float* w_ada, float* adaP, int item, int lane) {
    const int kc = item & (ADA_KC - 1), rest = item >> 5, cb = rest % 24, l = rest / 24;
    const float* W = w_ada + (size_t)l * DM * NIN + (size_t)(kc * 64) * NIN + cb * 256 + lane * 4;
    f32x4 acc = (f32x4){0.f, 0.f, 0.f, 0.f};
#pragma unroll 8
    for (int k = 0; k < 64; ++k) { const float cv = c[kc * 64 + k]; const float s = cv / (1.0f + expf(-cv)); const f32x4 w = *(const f32x4*)(W + (size_t)k * NIN); acc += w * s; }
    *(f32x4*)(adaP + ((size_t)(kc * 2 + l)) * NIN + cb * 256 + lane * 4) = acc;
}
__device__ __forceinline__ void p0_transpose_item(const float* W, int K, int N, bf16* WT, int row_off, LAS float* scr, int item, int lane) {
    const int nblk = N / 32, kb = item / nblk, nb = item % nblk, k0 = 64 * kb, n0 = 32 * nb;
#pragma unroll 8
    for (int i = 0; i < 32; ++i) { const int kk = 2 * i + (lane >> 5); scr[kk * 33 + (lane & 31)] = W[(size_t)(k0 + kk) * N + n0 + (lane & 31)]; }
    LDS_WAIT(); asm volatile("" ::: "memory");
    const int c = lane & 7;
#pragma unroll
    for (int j = 0; j < 4; ++j) { const int n = (lane >> 3) + 8 * j; const LAS float* s = scr + (8 * c) * 33 + n;
        v4u o; o.x = pk2(s[0 * 33], s[1 * 33]); o.y = pk2(s[2 * 33], s[3 * 33]); o.z = pk2(s[4 * 33], s[5 * 33]); o.w = pk2(s[6 * 33], s[7 * 33]);
        *(GAS v4u*)(WT + (size_t)(row_off + n0 + n) * K + k0 + 8 * c) = o; }
    LDS_WAIT(); asm volatile("" ::: "memory");
}
__device__ __forceinline__ void p0_s5_param(const Params& p, int idx) {
    const int l = idx >> 11, g = (idx >> 6) & 31, pp = idx & 63, lg = l * 32 + g;
    unsigned char* base = p.ws + WS_S5P + (size_t)l * S5P_STRIDE;
    const double dt = exp((double)p.in[I_S5LDT][lg]);
    const double lr = (double)p.in[I_S5LRE][lg * 64 + pp], li = (double)p.in[I_S5LIM][lg * 64 + pp];
    const double mag = exp(lr * dt), th = li * dt; const double ar = mag * cos(th), ai = mag * sin(th);
    const double den = lr * lr + li * li; const double fr = ((ar - 1.0) * lr + ai * li) / den, fi = (ai * lr - (ar - 1.0) * li) / den;
    ((f32x2*)(base + S5P_LAM1))[g * 64 + pp] = (f32x2){(float)ar, (float)ai};
    const double magL = exp(lr * dt * (double)S5_LC), thL = th * (double)S5_LC;
    ((f32x2*)(base + S5P_LAML))[g * 64 + pp] = (f32x2){(float)(magL * cos(thL)), (float)(magL * sin(thL))};
    bf16* bbT = (bf16*)(base + S5P_BBT) + (size_t)g * 128 * 16; bf16* cmT = (bf16*)(base + S5P_CMT) + (size_t)g * 16 * 128;
    const float* bre = p.in[I_S5BRE] + ((size_t)lg * 64 + pp) * 16; const float* bim = p.in[I_S5BIM] + ((size_t)lg * 64 + pp) * 16;
    for (int c = 0; c < 16; ++c) { const double br = bre[c], bi = bim[c];
        bbT[pp * 16 + c] = (bf16)f2bf((float)(fr * br - fi * bi)); bbT[(64 + pp) * 16 + c] = (bf16)f2bf((float)(fr * bi + fi * br)); }
    const float* cre = p.in[I_S5CRE] + (size_t)lg * 16 * 64; const float* cim = p.in[I_S5CIM] + (size_t)lg * 16 * 64;
    for (int c = 0; c < 16; ++c) { cmT[c * 128 + 2 * pp] = (bf16)f2bf(cre[c * 64 + pp]); cmT[c * 128 + 2 * pp + 1] = (bf16)f2bf(-cim[c * 64 + pp]); }
}
__device__ __forceinline__ void phase_p0(const Params& p, LAS unsigned char* lds, int gw, int NGW, int wave, int lane) {
    float* adaP = (float*)(p.ws + WS_ADAP);
    for (int it = gw; it < 2 * 24 * ADA_KC; it += NGW) p0_ada_item(p.in[I_C], p.in[I_WADA], adaP, it, lane);
    LAS float* scr = (LAS float*)(lds + wave * 16384);
    constexpr int I_IN = (DM / 64) * (NIN / 32), I_OUT = (DM / 64) * (DM / 32), I_GLU = (BR / 64) * (BR / 32), I_LRU = 2;
    constexpr int NITEMS = 2 * I_IN + 2 * I_OUT + 2 * I_GLU + 2 * 8 * 2 * I_LRU;
    for (int it = gw; it < NITEMS; it += NGW) {
        int r = it;
        if (r < 2 * I_IN) { const int l = r / I_IN; p0_transpose_item(p.in[I_WIN] + (size_t)l * DM * NIN, DM, NIN, (bf16*)(p.ws + WS_WIN) + (size_t)l * NIN * DM, 0, scr, r % I_IN, lane); continue; } r -= 2 * I_IN;
        if (r < 2 * I_OUT) { const int l = r / I_OUT; p0_transpose_item(p.in[I_WOUT] + (size_t)l * DM * DM, DM, DM, (bf16*)(p.ws + WS_WOUT) + (size_t)l * DM * DM, 0, scr, r % I_OUT, lane); continue; } r -= 2 * I_OUT;
        if (r < 2 * I_GLU) { const int l = r / I_GLU; p0_transpose_item(p.in[I_S5WGLU] + (size_t)l * BR * BR, BR, BR, (bf16*)(p.ws + WS_WGLU) + (size_t)l * BR * BR, 0, scr, r % I_GLU, lane); continue; } r -= 2 * I_GLU;
        { const int item = r & 1, mat = (r >> 1) & 1, lh = r >> 2;
          p0_transpose_item(p.in[mat ? I_LRUWX : I_LRUWA] + (size_t)lh * 64 * 64, 64, 64, (bf16*)(p.ws + WS_LRUW) + (size_t)lh * 128 * 64, mat * 64, scr, item, lane); }
    }
    const int gt = gw * 64 + lane, NGT = NGW * 64;
    for (int i = gt; i < 2 * 32 * 64; i += NGT) p0_s5_param(p, i);
    for (int i = gt; i < 2 * BR; i += NGT) { const int l = i / BR, ch = i % BR; const double lam = (double)p.in[I_LRULAM][i];
        ((float*)(p.ws + WS_S5P + (size_t)l * S5P_STRIDE + S5P_SP8))[ch] = (float)(8.0 * log1p(exp(-lam))); }
}

__device__ __forceinline__ void phase_p1(const Params& p, LAS unsigned char* lds, int bid, int G, int gw, int NGW, int tid, int lane) {
    const float* adaP = (const float*)(p.ws + WS_ADAP); float* adaF = (float*)(p.ws + WS_ADAF);
    LAS float* sv = (LAS float*)lds;
    for (int n = tid; n < 2 * DM; n += NTHR) { float s = p.in[I_BADA][n];
        for (int kc = 0; kc < ADA_KC; ++kc) s += adaP[(size_t)(kc * 2 + 0) * NIN + n];
        sv[n] = (n >= DM) ? 1.0f + s : s; }
    for (int i = bid * NTHR + tid; i < 2 * NIN; i += G * NTHR) { const int l = i / NIN, n = i % NIN; float s = p.in[I_BADA][i];
        for (int kc = 0; kc < ADA_KC; ++kc) s += adaP[(size_t)(kc * 2 + l) * NIN + n];
        adaF[i] = s; }
    __syncthreads();
    const float* x = p.in[I_X]; bf16* h = (bf16*)(p.ws + WS_H);
    for (int row = gw; row < SEQ; row += NGW) {
        const float* xr = x + (size_t)row * DM; bf16* hr = h + (size_t)row * DM;
#pragma unroll
        for (int j = 0; j < 4; ++j) { const int col = j * 512 + lane * 8;
            const f32x4 a = *(const f32x4*)(xr + col), b = *(const f32x4*)(xr + col + 4);
            const f32x4 sa = *(const LAS f32x4*)(sv + col), sb = *(const LAS f32x4*)(sv + col + 4), ca = *(const LAS f32x4*)(sv + DM + col), cb = *(const LAS f32x4*)(sv + DM + col + 4);
            const f32x4 ha = a * ca + sa, hb = b * cb + sb;
            v4u o; o.x = pk2(ha[0], ha[1]); o.y = pk2(ha[2], ha[3]); o.z = pk2(hb[0], hb[1]); o.w = pk2(hb[2], hb[3]);
            *(v4u*)(hr + col) = o; }
    }
}

__device__ __forceinline__ s16x4 vtr(const LAS bf16* pz) { typedef short v4i16_t __attribute__((ext_vector_type(4))); return __builtin_bit_cast(s16x4, __builtin_amdgcn_ds_read_tr16_b64_v4i16((LAS v4i16_t*)pz)); }
__device__ __forceinline__ unsigned cvtpk(float lo, float hi) { typedef __bf16 bf16x2_t __attribute__((ext_vector_type(2))); f32x2 v = {lo, hi}; bf16x2_t b = __builtin_convertvector(v, bf16x2_t); return __builtin_bit_cast(unsigned, b); }
constexpr int ATT_LD = 72;
__device__ __forceinline__ void phase_attn(const Params& p, LAS unsigned char* lds, int bid, int G, int tid, int wave, int lane) {
    LAS bf16* Ks = (LAS bf16*)lds; LAS bf16* Vs = (LAS bf16*)(lds + 256 * ATT_LD * 2); LAS float* biasT = (LAS float*)(lds + 2 * 256 * ATT_LD * 2);
    for (int i = tid; i < 3 * 8 * 129; i += NTHR) { const int grp = i / (8 * 129), rem = i % (8 * 129), hh = rem / 129, d = rem % 129;
        const int dil = grp == 0 ? 1 : (grp == 1 ? 4 : 16); const int dist = d * dil; int bucket;
        if (dist < 16) bucket = dist; else { const float nf = (float)dist; const float v = logf(nf / 16.0f) / 4.852030263919617f * 16.0f; bucket = 16 + (int)v; bucket = bucket < 31 ? bucket : 31; }
        biasT[(grp * 8 + hh) * 132 + d] = p.in[I_RELB][bucket * 8 + hh]; }
    __syncthreads();
    const bf16* proj = (const bf16*)(p.ws + WS_PROJ); bf16* og = (bf16*)(p.ws + WS_OG); float* lse = (float*)(p.ws + WS_LSE);
    const int l15 = lane & 15, g4 = lane >> 4;
    for (int it = bid; it < 1536; it += G) {
        const int grp = it >> 9, rem = it & 511, hh = rem & 7, idx = rem >> 3;
        const int dil = grp == 0 ? 1 : (grp == 1 ? 4 : 16), nbk = 64 / dil, r = idx / nbk, n = idx % nbk;
#pragma unroll
        for (int i = 0; i < 4; ++i) { const int cid = tid + NTHR * i, row = cid >> 3, ch = cid & 7; const int sub = (n - 1) * 128 + row;
            v4u kv = (v4u){0u, 0u, 0u, 0u}, vv = (v4u){0u, 0u, 0u, 0u};
            if (sub >= 0) { const size_t tok = (size_t)sub * dil + r; kv = *(const v4u*)(proj + tok * NIN + COL_K + hh * 64 + ch * 8); vv = *(const v4u*)(proj + tok * NIN + COL_V + hh * 64 + ch * 8); }
            *(LAS v4u*)(Ks + row * ATT_LD + ch * 8) = kv; *(LAS v4u*)(Vs + row * ATT_LD + ch * 8) = vv; }
        __syncthreads();
        const int iq = 16 * wave + l15; const size_t tokq = (size_t)(n * 128 + iq) * dil + r;
        bf16x8 qf[2];
#pragma unroll
        for (int s = 0; s < 2; ++s) qf[s] = *(const bf16x8*)(proj + tokq * NIN + COL_Q + hh * 64 + 32 * s + 8 * g4);
        f32x4 sc[10];
#pragma unroll
        for (int t = 0; t < 10; ++t) { int kt = wave + t; kt = kt < 15 ? kt : 15;
            const bf16x8 a0 = *(const LAS bf16x8*)(Ks + (kt * 16 + l15) * ATT_LD + 8 * g4), a1 = *(const LAS bf16x8*)(Ks + (kt * 16 + l15) * ATT_LD + 32 + 8 * g4);
            f32x4 acc = (f32x4){0.f, 0.f, 0.f, 0.f};
            acc = __builtin_amdgcn_mfma_f32_16x16x32_bf16(a0, qf[0], acc, 0, 0, 0);
            acc = __builtin_amdgcn_mfma_f32_16x16x32_bf16(a1, qf[1], acc, 0, 0, 0);
            sc[t] = acc; }
        const LAS float* bt = biasT + (grp * 8 + hh) * 132;
        float mx = -3.0e38f;
#pragma unroll
        for (int t = 0; t < 10; ++t)
#pragma unroll
            for (int q = 0; q < 4; ++q) { const int delta = l15 + 128 - 16 * t - 4 * g4 - q; const int j = 16 * (wave + t) + 4 * g4 + q;
                const bool valid = (delta >= 0) & (delta <= 128) & ((n > 0) | (j >= 128));
                const int dc = delta < 0 ? 0 : (delta > 128 ? 128 : delta);
                const float v = valid ? sc[t][q] * 0.125f + bt[dc] : -1.0e30f; sc[t][q] = v; mx = fmaxf(mx, v); }
        mx = fmaxf(mx, __shfl_xor(mx, 16)); mx = fmaxf(mx, __shfl_xor(mx, 32));
        float ls = 0.f;
#pragma unroll
        for (int t = 0; t < 10; ++t)
#pragma unroll
            for (int q = 0; q < 4; ++q) { const float e = __expf(sc[t][q] - mx); sc[t][q] = e; ls += e; }
        ls += __shfl_xor(ls, 16); ls += __shfl_xor(ls, 32);
        f32x4 o[4];
#pragma unroll
        for (int d0 = 0; d0 < 4; ++d0) o[d0] = (f32x4){0.f, 0.f, 0.f, 0.f};
        const int vq = l15 >> 2, vp = lane & 3;
#pragma unroll
        for (int pp = 0; pp < 5; ++pp) { const int ta = 2 * pp, tb = 2 * pp + 1; int ka = wave + ta, kb = wave + tb; ka = ka < 15 ? ka : 15; kb = kb < 15 ? kb : 15;
            v4u pw; pw.x = cvtpk(sc[ta][0], sc[ta][1]); pw.y = cvtpk(sc[ta][2], sc[ta][3]); pw.z = cvtpk(sc[tb][0], sc[tb][1]); pw.w = cvtpk(sc[tb][2], sc[tb][3]);
            const bf16x8 pf = __builtin_bit_cast(bf16x8, pw);
#pragma unroll
            for (int d0 = 0; d0 < 4; ++d0) { const s16x4 lo = vtr(Vs + (ka * 16 + 4 * g4 + vq) * ATT_LD + d0 * 16 + 4 * vp), hi = vtr(Vs + (kb * 16 + 4 * g4 + vq) * ATT_LD + d0 * 16 + 4 * vp);
                const bf16x8 vf = (bf16x8){lo[0], lo[1], lo[2], lo[3], hi[0], hi[1], hi[2], hi[3]};
                o[d0] = __builtin_amdgcn_mfma_f32_16x16x32_bf16(vf, pf, o[d0], 0, 0, 0); } }
        const float inv = 1.0f / ls;
        bf16* orow = og + ((size_t)grp * SEQ + tokq) * BR + hh * 64 + 4 * g4;
#pragma unroll
        for (int d0 = 0; d0 < 4; ++d0) { v2u w; w.x = pk2(o[d0][0] * inv, o[d0][1] * inv); w.y = pk2(o[d0][2] * inv, o[d0][3] * inv); *(v2u*)(orow + d0 * 16) = w; }
        if (g4 == 0) lse[((size_t)grp * SEQ + tokq) * 8 + hh] = mx + logf(ls);
        __syncthreads();
    }
}

__device__ __forceinline__ void phase_mixa(const Params& p, int l, int bid, int G, int tid) {
    const bf16* proj = (const bf16*)(p.ws + WS_PROJ); bf16* cat = (bf16*)(p.ws + WS_H);
    const int co = (tid & 63) * 8, tq = tid >> 6;
    float w[3][8];
#pragma unroll
    for (int j = 0; j < 3; ++j)
#pragma unroll
        for (int e = 0; e < 8; ++e) w[j][e] = p.in[I_CONVA][((size_t)l * 3 + j) * BR + co + e];
    for (int it = bid; it < SEQ / 32; it += G) {
        const int tb = it * 32 + tq * 4;
        float pr[6][8];
#pragma unroll
        for (int k = 0; k < 6; ++k) { const int tok = tb - 2 + k;
            if (tok >= 0) { const v4u a = *(const v4u*)(proj + (size_t)tok * NIN + COL_AC + co), b = *(const v4u*)(proj + (size_t)tok * NIN + COL_AX + co);
                pr[k][0] = bflo(a.x) * bflo(b.x); pr[k][1] = bfhi(a.x) * bfhi(b.x); pr[k][2] = bflo(a.y) * bflo(b.y); pr[k][3] = bfhi(a.y) * bfhi(b.y);
                pr[k][4] = bflo(a.z) * bflo(b.z); pr[k][5] = bfhi(a.z) * bfhi(b.z); pr[k][6] = bflo(a.w) * bflo(b.w); pr[k][7] = bfhi(a.w) * bfhi(b.w); }
            else {
#pragma unroll
                for (int e = 0; e < 8; ++e) pr[k][e] = 0.f; } }
#pragma unroll
        for (int k = 0; k < 4; ++k) { const size_t tok = (size_t)(tb + k);
            const v4u ab = *(const v4u*)(proj + tok * NIN + COL_AB + co), ag = *(const v4u*)(proj + tok * NIN + COL_AG + co);
            float y[8];
#pragma unroll
            for (int e = 0; e < 8; ++e) y[e] = w[0][e] * pr[k][e] + w[1][e] * pr[k + 1][e] + w[2][e] * pr[k + 2][e];
            v4u o;
            o.x = pk2(y[0] * bflo(ab.x) * bflo(ag.x), y[1] * bfhi(ab.x) * bfhi(ag.x)); o.y = pk2(y[2] * bflo(ab.y) * bflo(ag.y), y[3] * bfhi(ab.y) * bfhi(ag.y));
            o.z = pk2(y[4] * bflo(ab.z) * bflo(ag.z), y[5] * bfhi(ab.z) * bfhi(ag.z)); o.w = pk2(y[6] * bflo(ab.w) * bflo(ag.w), y[7] * bfhi(ab.w) * bfhi(ag.w));
            *(v4u*)(cat + tok * DM + co) = o; }
    }
}
__device__ __forceinline__ void phase_attn_combine(const Params& p, int bid, int G, int tid) {
    const bf16* proj = (const bf16*)(p.ws + WS_PROJ); bf16* cat = (bf16*)(p.ws + WS_H); const bf16* og = (const bf16*)(p.ws + WS_OG); const float* lse = (const float*)(p.ws + WS_LSE);
    for (int it = bid; it < SEQ / 32; it += G) {
#pragma unroll
        for (int i = 0; i < 4; ++i) { const int pair = tid + NTHR * i; const size_t tok = (size_t)it * 32 + (pair >> 6); const int oc = pair & 63, hh = oc >> 3;
            const float l0 = lse[(0 * (size_t)SEQ + tok) * 8 + hh], l1 = lse[(1 * (size_t)SEQ + tok) * 8 + hh], l2 = lse[(2 * (size_t)SEQ + tok) * 8 + hh];
            const float m = fmaxf(l0, fmaxf(l1, l2)); float w0 = __expf(l0 - m), w1 = __expf(l1 - m), w2 = __expf(l2 - m); const float inv = 1.0f / (w0 + w1 + w2); w0 *= inv; w1 *= inv; w2 *= inv;
            const v4u a = *(const v4u*)(og + (0 * (size_t)SEQ + tok) * BR + oc * 8), b = *(const v4u*)(og + (1 * (size_t)SEQ + tok) * BR + oc * 8), c = *(const v4u*)(og + (2 * (size_t)SEQ + tok) * BR + oc * 8);
            const v4u gt = *(const v4u*)(proj + tok * NIN + COL_BG + oc * 8);
            v4u o;
            o.x = pk2((w0 * bflo(a.x) + w1 * bflo(b.x) + w2 * bflo(c.x)) * bflo(gt.x), (w0 * bfhi(a.x) + w1 * bfhi(b.x) + w2 * bfhi(c.x)) * bfhi(gt.x));
            o.y = pk2((w0 * bflo(a.y) + w1 * bflo(b.y) + w2 * bflo(c.y)) * bflo(gt.y), (w0 * bfhi(a.y) + w1 * bfhi(b.y) + w2 * bfhi(c.y)) * bfhi(gt.y));
            o.z = pk2((w0 * bflo(a.z) + w1 * bflo(b.z) + w2 * bflo(c.z)) * bflo(gt.z), (w0 * bfhi(a.z) + w1 * bfhi(b.z) + w2 * bfhi(c.z)) * bfhi(gt.z));
            o.w = pk2((w0 * bflo(a.w) + w1 * bflo(b.w) + w2 * bflo(c.w)) * bflo(gt.w), (w0 * bfhi(a.w) + w1 * bfhi(b.w) + w2 * bfhi(c.w)) * bfhi(gt.w));
            *(v4u*)(cat + tok * DM + BR + oc * 8) = o; }
    }
}

constexpr int LRU_XB_LD = 72;
constexpr int LRU_WAVE_LDS = 32 * 64 * 4 + 32 * LRU_XB_LD * 2;
template <bool PASS2>
__device__ __forceinline__ void lru_item(const Params& p, int l, LAS unsigned char* wl, int c, int hd, int lane) {
    LAS float* xcf = (LAS float*)wl; LAS bf16* xcb = (LAS bf16*)(wl + 32 * 64 * 4);
    const bf16* proj = (const bf16*)(p.ws + WS_PROJ); bf16* cat = (bf16*)(p.ws + WS_H);
    float* lruA = (float*)(p.ws + WS_LRUC); float* lruH = lruA + LRU_NC * BR;
    const bf16* wT = (const bf16*)(p.ws + WS_LRUW) + (size_t)(l * 8 + hd) * 128 * 64;
    const float* sp8 = (const float*)(p.ws + WS_S5P + (size_t)l * S5P_STRIDE + S5P_SP8);
    const int s = lane & 31, hf = lane >> 5, chl = hd * 64 + lane;
    float cw[4];
#pragma unroll
    for (int j = 0; j < 4; ++j) cw[j] = p.in[I_CONVC][((size_t)l * 4 + j) * BR + chl];
    const float cbias = p.in[I_CONVCB][(size_t)l * BR + chl];
    float ba[2], bx[2], sp[2], H[2], Ap[2];
#pragma unroll
    for (int e = 0; e < 2; ++e) { const int ch = hd * 64 + s + 32 * e; ba[e] = p.in[I_LRUBA][(size_t)l * BR + ch]; bx[e] = p.in[I_LRUBX][(size_t)l * BR + ch]; sp[e] = sp8[ch]; H[e] = 0.f; Ap[e] = 1.f; }
    if (PASS2) {
#pragma unroll
        for (int e = 0; e < 2; ++e) { const int ch = hd * 64 + s + 32 * e; float h = 0.f;
#pragma unroll 8
            for (int cc = 0; cc < c; ++cc) h = lruA[(size_t)cc * BR + ch] * h + lruH[(size_t)cc * BR + ch];
            H[e] = h; }
    }
    const int t00 = c * LRU_LC;
    float xm3 = 0.f, xm2 = 0.f, xm1 = 0.f;
    if (t00 > 0) { xm3 = bf2f(proj[(size_t)(t00 - 3) * NIN + COL_CX + chl]); xm2 = bf2f(proj[(size_t)(t00 - 2) * NIN + COL_CX + chl]); xm1 = bf2f(proj[(size_t)(t00 - 1) * NIN + COL_CX + chl]); }
    for (int tile = 0; tile < LRU_LC / 32; ++tile) {
        const int t0 = t00 + tile * 32;
#pragma unroll 8
        for (int t = 0; t < 32; ++t) { const float xv = bf2f(proj[(size_t)(t0 + t) * NIN + COL_CX + chl]);
            const float xc = cw[0] * xm3 + cw[1] * xm2 + cw[2] * xm1 + cw[3] * xv + cbias; xm3 = xm2; xm2 = xm1; xm1 = xv;
            xcf[t * 64 + lane] = xc; xcb[t * LRU_XB_LD + lane] = (bf16)f2bf(xc); }
        LDS_WAIT(); asm volatile("" ::: "memory");
        bf16x8 af[4];
#pragma unroll
        for (int ks = 0; ks < 4; ++ks) af[ks] = *(const LAS bf16x8*)(xcb + s * LRU_XB_LD + ks * 16 + 8 * hf);
#pragma unroll
        for (int e = 0; e < 2; ++e) {
            f32x16 accr, acci;
#pragma unroll
            for (int q = 0; q < 16; ++q) { accr[q] = 0.f; acci[q] = 0.f; }
#pragma unroll
            for (int ks = 0; ks < 4; ++ks) { const bf16x8 br = *(const bf16x8*)(wT + (size_t)(32 * e + s) * 64 + ks * 16 + 8 * hf), bi = *(const bf16x8*)(wT + (size_t)(64 + 32 * e + s) * 64 + ks * 16 + 8 * hf);
                accr = __builtin_amdgcn_mfma_f32_32x32x16_bf16(af[ks], br, accr, 0, 0, 0); acci = __builtin_amdgcn_mfma_f32_32x32x16_bf16(af[ks], bi, acci, 0, 0, 0); }
            float av[16], bv[16];
#pragma unroll
            for (int q = 0; q < 16; ++q) { const int tt = (q & 3) + 8 * (q >> 2) + 4 * hf;
                const float rg = sigm(accr[q] + ba[e]), ig = sigm(acci[q] + bx[e]);
                const float la = -rg * sp[e]; const float a = __expf(la); const float z = 2.0f * la;
                const float em = z * (1.0f + z * (1.0f / 2.0f) * (1.0f + z * (1.0f / 3.0f) * (1.0f + z * 0.25f * (1.0f + z * 0.2f * (1.0f + z * (1.0f / 6.0f) * (1.0f + z * (1.0f / 7.0f)))))));
                const float one_m = (z > -0.3f) ? -em : (1.0f - __expf(z));
                av[q] = a; bv[q] = sqrtf(one_m) * ig * xcf[tt * 64 + s + 32 * e]; }
            float h = H[e];
#pragma unroll
            for (int j = 0; j < 4; ++j) {
                float e0 = h;
#pragma unroll
                for (int q = 0; q < 4; ++q) e0 = av[4 * j + q] * e0 + bv[4 * j + q];
                const float e0o = __shfl_xor(e0, 32);
                float xs = hf ? e0o : h;
#pragma unroll
                for (int q = 0; q < 4; ++q) { xs = av[4 * j + q] * xs + bv[4 * j + q]; bv[4 * j + q] = xs; }
                const float xo = __shfl_xor(xs, 32);
                h = hf ? xs : xo;
            }
            H[e] = h;
            if (!PASS2) { float pa = 1.f;
#pragma unroll
                for (int q = 0; q < 16; ++q) pa *= av[q];
                pa *= __shfl_xor(pa, 32); Ap[e] *= pa; }
            else {
#pragma unroll
                for (int q = 0; q < 16; ++q) { const int tt = (q & 3) + 8 * (q >> 2) + 4 * hf; const size_t tok = (size_t)(t0 + tt); const int ch = hd * 64 + s + 32 * e;
                    const float gsv = bf2f(proj[tok * NIN + COL_CG + ch]);
                    cat[tok * DM + 2 * BR + ch] = (bf16)f2bf(bv[q] * gsv); } }
        }
        LDS_WAIT(); asm volatile("" ::: "memory");
    }
    if (!PASS2 && hf == 0) {
#pragma unroll
        for (int e = 0; e < 2; ++e) { const int ch = hd * 64 + s + 32 * e; lruA[(size_t)c * BR + ch] = Ap[e]; lruH[(size_t)c * BR + ch] = H[e]; } }
}

constexpr int S5_X_LD = 136;
constexpr int S5_WAVE_LDS = 32 * S5_X_LD * 2;
template <bool PASS2>
__device__ __forceinline__ void s5_item(const Params& p, int l, LAS unsigned char* wl, int c, int g, int lane) {
    LAS bf16* Xt = (LAS bf16*)wl;
    const bf16* proj = (const bf16*)(p.ws + WS_PROJ); bf16* yg = (bf16*)(p.ws + WS_YG); float* s5x = (float*)(p.ws + WS_S5C);
    const unsigned char* pb = p.ws + WS_S5P + (size_t)l * S5P_STRIDE;
    const f32x2* lam1 = (const f32x2*)(pb + S5P_LAM1) + g * 64; const f32x2* lamL = (const f32x2*)(pb + S5P_LAML) + g * 64;
    const bf16* bbT = (const bf16*)(pb + S5P_BBT) + (size_t)g * 128 * 16; const bf16* cmT = (const bf16*)(pb + S5P_CMT) + (size_t)g * 16 * 128;
    const int s = lane & 31, hf = lane >> 5, l15 = lane & 15, g4 = lane >> 4;
    bf16x8 bb[4];
#pragma unroll
    for (int nb = 0; nb < 4; ++nb) bb[nb] = *(const bf16x8*)(bbT + (size_t)(nb * 32 + s) * 16 + 8 * hf);
    float lr[2], li[2], xr[2], xi[2];
#pragma unroll
    for (int e = 0; e < 2; ++e) { const f32x2 v = lam1[s + 32 * e]; lr[e] = v.x; li[e] = v.y; xr[e] = 0.f; xi[e] = 0.f; }
    if (PASS2) {
#pragma unroll
        for (int e = 0; e < 2; ++e) { const f32x2 v = lamL[s + 32 * e]; const float ar = v.x, ai = v.y; float hr = 0.f, hi = 0.f; const int pidx = s + 32 * e;
#pragma unroll 8
            for (int cc = 0; cc < c; ++cc) { const float ur = s5x[((size_t)cc * 32 + g) * 128 + pidx], ui = s5x[((size_t)cc * 32 + g) * 128 + 64 + pidx];
                const float nr = ar * hr - ai * hi + ur, ni = ar * hi + ai * hr + ui; hr = nr; hi = ni; }
            xr[e] = hr; xi[e] = hi; }
    }
    bf16x8 cm[4]; float dsk = 0.f;
    if (PASS2) {
#pragma unroll
        for (int ks = 0; ks < 4; ++ks) cm[ks] = *(const bf16x8*)(cmT + (size_t)l15 * 128 + ks * 32 + 8 * g4);
        dsk = p.in[I_S5D][(size_t)l * BR + g * 16 + l15];
    }
    for (int tile = 0; tile < S5_LC / 32; ++tile) {
        const int t0 = c * S5_LC + tile * 32;
        const bf16x8 uf = *(const bf16x8*)(proj + (size_t)(t0 + s) * NIN + COL_DU + g * 16 + 8 * hf);
        f32x16 zero16;
#pragma unroll
        for (int q = 0; q < 16; ++q) zero16[q] = 0.f;
#pragma unroll
        for (int e = 0; e < 2; ++e) {
            f32x16 br = __builtin_amdgcn_mfma_f32_32x32x16_bf16(uf, bb[e], zero16, 0, 0, 0);
            f32x16 bi = __builtin_amdgcn_mfma_f32_32x32x16_bf16(uf, bb[2 + e], zero16, 0, 0, 0);
            float hr = xr[e], hi = xi[e]; const float ar = lr[e], ai = li[e];
#pragma unroll
            for (int j = 0; j < 4; ++j) {
                float er = hr, ei = hi;
#pragma unroll
                for (int q = 0; q < 4; ++q) { const float nr = ar * er - ai * ei + br[4 * j + q], ni = ar * ei + ai * er + bi[4 * j + q]; er = nr; ei = ni; }
                const float ero = __shfl_xor(er, 32), eio = __shfl_xor(ei, 32);
                float sr = hf ? ero : hr, si = hf ? eio : hi;
#pragma unroll
                for (int q = 0; q < 4; ++q) { const float nr = ar * sr - ai * si + br[4 * j + q], ni = ar * si + ai * sr + bi[4 * j + q]; sr = nr; si = ni;
                    if (PASS2) { const int tt = q + 8 * j + 4 * hf; *(LAS unsigned*)(Xt + tt * S5_X_LD + 2 * (s + 32 * e)) = pk2(sr, si); } }
                const float sro = __shfl_xor(sr, 32), sio = __shfl_xor(si, 32);
                hr = hf ? sr : sro; hi = hf ? si : sio;
            }
            xr[e] = hr; xi[e] = hi;
        }
        if (PASS2) {
            LDS_WAIT(); asm volatile("" ::: "memory");
#pragma unroll
            for (int rt = 0; rt < 2; ++rt) {
                f32x4 acc = (f32x4){0.f, 0.f, 0.f, 0.f};
#pragma unroll
                for (int ks = 0; ks < 4; ++ks) { const bf16x8 a = *(const LAS bf16x8*)(Xt + (rt * 16 + l15) * S5_X_LD + ks * 32 + 8 * g4);
                    acc = __builtin_amdgcn_mfma_f32_16x16x32_bf16(a, cm[ks], acc, 0, 0, 0); }
#pragma unroll
                for (int q = 0; q < 4; ++q) { const size_t tok = (size_t)(t0 + rt * 16 + 4 * g4 + q); const float u = bf2f(proj[tok * NIN + COL_DU + g * 16 + l15]);
                    const float y = acc[q] + dsk * u; const float yy = y * sigm(1.5957691216057308f * (y + 0.044715f * y * y * y));
                    yg[tok * BR + g * 16 + l15] = (bf16)f2bf(yy); }
            }
            LDS_WAIT(); asm volatile("" ::: "memory");
        }
    }
    if (!PASS2 && hf == 0) {
#pragma unroll
        for (int e = 0; e < 2; ++e) { s5x[((size_t)c * 32 + g) * 128 + s + 32 * e] = xr[e]; s5x[((size_t)c * 32 + g) * 128 + 64 + s + 32 * e] = xi[e]; } }
}

__device__ __forceinline__ void phase_ln(const Params& p, int l, int gw, int NGW, int lane) {
    float* z = p.out; bf16* h = (bf16*)(p.ws + WS_H); const float* lg = p.in[I_LNG] + (size_t)l * DM; const float* lb = p.in[I_LNB] + (size_t)l * DM;
    const float* adaF = (const float*)(p.ws + WS_ADAF) + (size_t)(l + 1 < DEPTH ? l + 1 : l) * NIN;
    for (int row = gw; row < SEQ; row += NGW) {
        float* zr = z + (size_t)row * DM + 4 * lane;
        f32x4 v[8]; float s = 0.f;
#pragma unroll
        for (int j = 0; j < 8; ++j) { v[j] = *(const f32x4*)(zr + 256 * j); s += (v[j][0] + v[j][1]) + (v[j][2] + v[j][3]); }
#pragma unroll
        for (int o = 1; o < 64; o <<= 1) s += __shfl_xor(s, o);
        const float mean = s * (1.0f / DM); float q = 0.f;
#pragma unroll
        for (int j = 0; j < 8; ++j) { v[j] = v[j] - mean; q += (v[j][0] * v[j][0] + v[j][1] * v[j][1]) + (v[j][2] * v[j][2] + v[j][3] * v[j][3]); }
#pragma unroll
        for (int o = 1; o < 64; o <<= 1) q += __shfl_xor(q, o);
        const float rstd = 1.0f / sqrtf(q * (1.0f / DM) + LN_EPS);
#pragma unroll
        for (int j = 0; j < 8; ++j) { const int col = 4 * lane + 256 * j; const f32x4 gg = *(const f32x4*)(lg + col), bb = *(const f32x4*)(lb + col);
            const f32x4 o = v[j] * rstd * gg + bb; *(f32x4*)(zr + 256 * j) = o;
            if (l + 1 < DEPTH) { const f32x4 sh = *(const f32x4*)(adaF + col), sc = *(const f32x4*)(adaF + DM + col); const f32x4 hv = o * (sc + 1.0f) + sh;
                v2u w; w.x = pk2(hv[0], hv[1]); w.y = pk2(hv[2], hv[3]); *(v2u*)(h + (size_t)row * DM + col) = w; } }
    }
}

constexpr int NPHASE = 2 + 6 * DEPTH;
__global__ void __launch_bounds__(NTHR, 2) mk_fwd(Params p_) {
    extern __shared__ __attribute__((aligned(16))) unsigned char lds_raw[];
    LAS unsigned char* lds = (LAS unsigned char*)lds_raw;
    const int G = gridDim.x, bid = blockIdx.x;
    const int vcu = (G % 8 == 0) ? (bid % 8) * (G / 8) + bid / 8 : bid;
    const int NGW = G * NWAVES;
    volatile LAS unsigned* MISC = (volatile LAS unsigned*)(lds + MISC_OFF);
    for (int u = threadIdx.x; u < (LDS_BYTES - LDSCTL_OFF) / 4; u += NTHR) ((LAS unsigned*)(lds + LDSCTL_OFF))[u] = 0u;
#define IDS() int tid = threadIdx.x; asm volatile("" : "+v"(tid)); const int lane = tid & 63, wave = __builtin_amdgcn_readfirstlane(tid >> 6), gw = vcu * NWAVES + wave; (void)lane; (void)gw; \
              Params p = p_; { unsigned long long z_ = 0; asm volatile("" : "+s"(z_)); p.ws = p_.ws + z_; }
    __syncthreads();
    XcdBarrier bar; bar.bar = (unsigned*)(p_.ws + WS_CTL) + CW_BAR; bar.x = 0; bar.st = nullptr;
    const int lo = p_.ph_lo, hi = p_.ph_hi;
    if (hi - lo > 1) bar = xcd_barrier_post((unsigned*)(p_.ws + WS_CTL) + CW_BAR, MISC + 8);
#ifndef PHMASK
#define PHMASK 0x1FFF
#endif
#define EN(t) (((PHMASK) >> (t)) & 1)
#define IN(k) (lo <= (k) && (k) < hi)
#define SEAM(k) do { if (IN(k) && IN((k) + 1)) xcd_barrier(bar); } while (0)
    if (EN(0) && IN(0)) { IDS(); phase_p0(p, lds, gw, NGW, wave, lane); } SEAM(0);
    if (EN(1) && IN(1)) { IDS(); phase_p1(p, lds, vcu, G, gw, NGW, tid, lane); } SEAM(1);
#pragma unroll
    for (int l = 0; l < DEPTH; ++l) {
        const int pb = 2 + 6 * l;
        if (EN(2) && IN(pb + 0)) { IDS();
            pg8::Gemm g{(const pg8::bf16_t*)(p.ws + WS_H), (const pg8::bf16_t*)(p.ws + WS_WIN) + (size_t)l * NIN * DM, SEQ, NIN, DM}; pg8::StaticOrder S; S.init(SEQ, NIN, G, bid);
            pg8::EpiProj E{(pg8::bf16_t*)(p.ws + WS_PROJ), NIN};
            pg8::gemm_phase<pg8::EpiProj, pg8::StaticOrder, true, true>(lds, g, S, E);
        } SEAM(pb + 0);
        if (IN(pb + 1)) { IDS();
            if (EN(3)) phase_attn(p, lds, vcu, G, tid, wave, lane);
            __syncthreads();
            if (EN(4)) for (int it = gw; it < LRU_NC * 8; it += NGW) lru_item<false>(p, l, lds + wave * LRU_WAVE_LDS, it >> 3, it & 7, lane);
            __syncthreads();
            if (EN(5)) for (int it = gw; it < S5_NC * 32; it += NGW) s5_item<false>(p, l, lds + wave * S5_WAVE_LDS, it >> 5, it & 31, lane);
            if (EN(6)) phase_mixa(p, l, vcu, G, tid);
        } SEAM(pb + 1);
        if (IN(pb + 2)) { IDS();
            if (EN(7)) for (int it = gw; it < S5_NC * 32; it += NGW) s5_item<true>(p, l, lds + wave * S5_WAVE_LDS, it >> 5, it & 31, lane);
            __syncthreads();
            if (EN(8)) for (int it = gw; it < LRU_NC * 8; it += NGW) lru_item<true>(p, l, lds + wave * LRU_WAVE_LDS, it >> 3, it & 7, lane);
            if (EN(9)) phase_attn_combine(p, vcu, G, tid);
        } SEAM(pb + 2);
        if (EN(10) && IN(pb + 3)) { IDS();
            __syncthreads();
            pg8::Gemm g{(const pg8::bf16_t*)(p.ws + WS_YG), (const pg8::bf16_t*)(p.ws + WS_WGLU) + (size_t)l * BR * BR, SEQ, BR, BR}; pg8::StaticOrder S; S.init(SEQ, BR, G, bid);
            pg8::EpiGlu E{(pg8::bf16_t*)(p.ws + WS_H) + 3 * BR, DM, (const pg8::bf16_t*)(p.ws + WS_YG), BR, (const pg8::bf16_t*)(p.ws + WS_PROJ) + COL_DG, NIN, p.in[I_S5BGLU] + (size_t)l * BR};
            pg8::gemm_phase<pg8::EpiGlu, pg8::StaticOrder, true, true>(lds, g, S, E);
        } SEAM(pb + 3);
        if (EN(11) && IN(pb + 4)) { IDS();
            pg8::Gemm g{(const pg8::bf16_t*)(p.ws + WS_H), (const pg8::bf16_t*)(p.ws + WS_WOUT) + (size_t)l * DM * DM, SEQ, DM, DM}; pg8::StaticOrder S; S.init(SEQ, DM, G, bid);
            pg8::EpiRes E{l == 0 ? p.in[I_X] : p.out, p.out, DM, (const float*)(p.ws + WS_ADAF) + (size_t)l * NIN + 2 * DM, ALPHA};
            pg8::gemm_phase<pg8::EpiRes, pg8::StaticOrder, true, true>(lds, g, S, E);
        } SEAM(pb + 4);
        if (EN(12) && IN(pb + 5)) { IDS(); phase_ln(p, l, gw, NGW, lane); } SEAM(pb + 5);
    }
#undef IN
#undef EN
#undef IDS
#undef SEAM
}

extern "C" void kernel_launch(void* const* d_in, const int* in_sizes, int n_in, void* d_out, int out_size, void* d_ws, size_t ws_size, hipStream_t stream) {
    static int grid = 0;
    if (grid == 0) {
        if (n_in != 27 || out_size != SEQ * DM || ws_size < WS_END) { fprintf(stderr, "kernel_launch: unexpected problem (n_in %d, out %d, ws %zu); nothing launched\n", n_in, out_size, ws_size); grid = -1; return; }
        int dev = 0, cus = 0, per_cu = 0;
        if (hipGetDevice(&dev) != hipSuccess || hipDeviceGetAttribute(&cus, hipDeviceAttributeMultiprocessorCount, dev) != hipSuccess) { grid = -1; return; }
        if (hipFuncSetAttribute((const void*)mk_fwd, hipFuncAttributeMaxDynamicSharedMemorySize, LDS_BYTES) != hipSuccess) { fprintf(stderr, "kernel_launch: hipFuncSetAttribute failed\n"); grid = -1; return; }
        if (hipOccupancyMaxActiveBlocksPerMultiprocessor(&per_cu, (const void*)mk_fwd, NTHR, LDS_BYTES) != hipSuccess || per_cu < 1) { fprintf(stderr, "kernel_launch: occupancy query says %d blocks per CU\n", per_cu); }
        (void)hipGetLastError();
        grid = cus;
    }
    if (grid < 0) return;
    (void)hipMemsetAsync((char*)d_ws + WS_CTL, 0, CTL_ZERO_BYTES, stream);
    Params a{};
    for (int i = 0; i < 27; ++i) a.in[i] = (const float*)d_in[i];
    a.out = (float*)d_out; a.ws = (unsigned char*)d_ws;
#if MK_FUSED
    a.ph_lo = 0; a.ph_hi = NPHASE;
    hipLaunchKernelGGL(mk_fwd, dim3(grid), dim3(NTHR), LDS_BYTES, stream, a);
#else
    for (int k = 0; k < NPHASE; ++k) { a.ph_lo = k; a.ph_hi = k + 1; hipLaunchKernelGGL(mk_fwd, dim3(grid), dim3(NTHR), LDS_BYTES, stream, a); }
#endif
}
```

```cpp
#include <hip/hip_runtime.h>
#include <cstdio>
#include <cstdint>
namespace pg8 {
#define PG8_LAS __attribute__((address_space(3)))
typedef unsigned short bf16_t;
typedef short bf16x8 __attribute__((ext_vector_type(8)));
typedef float f32x4 __attribute__((ext_vector_type(4)));
typedef unsigned u32x4 __attribute__((ext_vector_type(4)));
constexpr int BM = 256, BK = 64, HALF = 128, HTB = HALF * BK * 2  , STAGE_BYTES = 8 * HTB, NXCD = 8, WGM = 8;

__host__ __device__ __forceinline__ int lds_byte(int r, int c) { const int st = (r >> 4) * 2 + (c >> 5), rr = r & 15, cc = c & 31, ob = rr * 64 + cc * 2; return st * 1024 + (ob ^ (((ob >> 9) & 1) << 5)); }
__host__ __device__ __forceinline__ void stage_rc(int b, int& R, int& C) { const int st = b / 1024, sb = b % 1024, swz = sb ^ (((sb >> 9) & 1) << 5); R = (st >> 1) * 16 + swz / 64; C = (st & 1) * 32 + (swz % 64) / 2; }
__host__ __device__ __forceinline__ int perm32(int rho) { const int n = rho >> 4, i = rho & 15; return 8 * (i >> 2) + 4 * n + (i & 3); }

struct Unit { int pm, pn; };
struct Gemm { const bf16_t* A; const bf16_t* Bt; int M, N, K; };

struct StaticOrder {
    int nM, nN, nwg, G, c;
    __host__ __device__ void init(int M, int N, int G_, int c_) { nM = M / BM; nN = N / BM; nwg = nM * nN; G = G_; c = c_; }
    __host__ __device__ bool next(int i, Unit& u) const {
        const long L = (long)i * G + c; if (L >= nwg) return false;
        int wgid = (int)L; { const int q = nwg / NXCD, r = nwg % NXCD, xcd = wgid % NXCD, off = wgid / NXCD; wgid = (xcd < r ? xcd * (q + 1) : r * (q + 1) + (xcd - r) * q) + off; }
        const int nig = WGM * nN, gid = wgid / nig, fm = gid * WGM, gsz = (nM - fm) < WGM ? (nM - fm) : WGM;
        u.pm = fm + ((wgid % nig) % gsz); u.pn = (wgid % nig) / gsz; return true;
    }
    __device__ __forceinline__ void a_ready(const Unit&) const {}
    __device__ __forceinline__ void done(const Unit&) const {}
};

__device__ __forceinline__ unsigned cvt_pk_bf16(float lo, float hi) { unsigned r; asm volatile("v_cvt_pk_bf16_f32 %0, %1, %2" : "=v"(r) : "v"(lo), "v"(hi)); return r; }
typedef float f32x2 __attribute__((ext_vector_type(2)));

__device__ __forceinline__ float silu_f(float v) { return v * __builtin_amdgcn_rcpf(1.0f + __expf(-v)); }
__device__ __forceinline__ float sigm_f(float v) { return __builtin_amdgcn_rcpf(1.0f + __expf(-v)); }
__device__ __forceinline__ float bflo(unsigned w) { return __uint_as_float(w << 16); }
__device__ __forceinline__ float bfhi(unsigned w) { return __uint_as_float(w & 0xffff0000u); }

struct EpiProj {
    static constexpr bool PERM = true, AFTER_DRAIN = false;
    bf16_t* O; int ldc;
    __device__ __forceinline__ void operator()(const f32x4 (&acc)[2][2][4][2], const Unit& u, int wr, int wc, int fr, int fq) const {
        const int row0 = u.pm * BM + wr * 64 + fr, col0 = u.pn * BM + wc * 32 + 8 * fq;
        const int pn = u.pn; const bool gate = (pn == 6) | (pn == 7) | (pn == 14) | (pn == 15) | (pn == 18) | (pn == 19) | (pn == 22) | (pn == 23);
#pragma unroll
        for (int ai = 0; ai < 2; ++ai)
#pragma unroll
            for (int m = 0; m < 4; ++m) { bf16_t* rowp = O + (size_t)(row0 + ai * HALF + m * 16) * ldc + col0;
#pragma unroll
                for (int bj = 0; bj < 2; ++bj) { f32x4 v0 = acc[ai][bj][m][0], v1 = acc[ai][bj][m][1];
                    if (gate) {
#pragma unroll
                        for (int j = 0; j < 4; ++j) { v0[j] = silu_f(v0[j]); v1[j] = silu_f(v1[j]); } }
                    u32x4 w; w.x = cvt_pk_bf16(v0[0], v0[1]); w.y = cvt_pk_bf16(v0[2], v0[3]); w.z = cvt_pk_bf16(v1[0], v1[1]); w.w = cvt_pk_bf16(v1[2], v1[3]);
                    *(u32x4*)(rowp + bj * HALF) = w; } }
    }
};
struct EpiGlu {
    static constexpr bool PERM = true, AFTER_DRAIN = false;
    bf16_t* O; int ldo; const bf16_t* Y; int ldy; const bf16_t* G; int ldg; const float* bias;
    __device__ __forceinline__ void operator()(const f32x4 (&acc)[2][2][4][2], const Unit& u, int wr, int wc, int fr, int fq) const {
        const int row0 = u.pm * BM + wr * 64 + fr, col0 = u.pn * BM + wc * 32 + 8 * fq;
        f32x4 bv[2][2];
#pragma unroll
        for (int bj = 0; bj < 2; ++bj)
#pragma unroll
            for (int n = 0; n < 2; ++n) bv[bj][n] = *(const f32x4*)(bias + col0 + bj * HALF + 4 * n);
#pragma unroll
        for (int ai = 0; ai < 2; ++ai)
#pragma unroll
            for (int m = 0; m < 4; ++m) { const size_t row = (size_t)(row0 + ai * HALF + m * 16);
#pragma unroll
                for (int bj = 0; bj < 2; ++bj) { const int col = col0 + bj * HALF;
                    const u32x4 yv = *(const u32x4*)(Y + row * ldy + col), gv = *(const u32x4*)(G + row * ldg + col);
                    const f32x4 v0 = acc[ai][bj][m][0] + bv[bj][0], v1 = acc[ai][bj][m][1] + bv[bj][1];
                    u32x4 w;
                    w.x = cvt_pk_bf16(bflo(yv.x) * sigm_f(v0[0]) * bflo(gv.x), bfhi(yv.x) * sigm_f(v0[1]) * bfhi(gv.x));
                    w.y = cvt_pk_bf16(bflo(yv.y) * sigm_f(v0[2]) * bflo(gv.y), bfhi(yv.y) * sigm_f(v0[3]) * bfhi(gv.y));
                    w.z = cvt_pk_bf16(bflo(yv.z) * sigm_f(v1[0]) * bflo(gv.z), bfhi(yv.z) * sigm_f(v1[1]) * bfhi(gv.z));
                    w.w = cvt_pk_bf16(bflo(yv.w) * sigm_f(v1[2]) * bflo(gv.w), bfhi(yv.w) * sigm_f(v1[3]) * bfhi(gv.w));
                    *(u32x4*)(O + row * ldo + col) = w; } }
    }
};
struct EpiRes {
    static constexpr bool PERM = false, AFTER_DRAIN = false;
    const float* X; float* Z; int ldc; const float* gate; float alpha;
    __device__ __forceinline__ void operator()(const f32x4 (&acc)[2][2][4][2], const Unit& u, int wr, int wc, int fr, int fq) const {
        const int row0 = u.pm * BM + wr * 64 + fr, col0 = u.pn * BM + wc * 32 + 4 * fq;
        f32x4 gv[2][2];
#pragma unroll
        for (int bj = 0; bj < 2; ++bj)
#pragma unroll
            for (int n = 0; n < 2; ++n) gv[bj][n] = *(const f32x4*)(gate + col0 + bj * HALF + n * 16) + 1.0f;
#pragma unroll
        for (int ai = 0; ai < 2; ++ai)
#pragma unroll
            for (int m = 0; m < 4; ++m) { const size_t off = (size_t)(row0 + ai * HALF + m * 16) * ldc + col0;
#pragma unroll
                for (int bj = 0; bj < 2; ++bj)
#pragma unroll
                    for (int n = 0; n < 2; ++n) { const f32x4 xv = *(const f32x4*)(X + off + bj * HALF + n * 16);
                        *(f32x4*)(Z + off + bj * HALF + n * 16) = xv * alpha + gv[bj][n] * acc[ai][bj][m][n]; } }
    }
};

template <class Epi, class Sched, bool ALIGN_EPI = false, bool SP2 = false>
__device__ __forceinline__ void gemm_phase(PG8_LAS unsigned char* lds, const Gemm g, const Sched& S, const Epi& E) {
    int tid_ = threadIdx.x; asm volatile("" : "+v"(tid_));
    const int tid = tid_, wid = __builtin_amdgcn_readfirstlane(tid >> 6), lane = tid & 63, wr = wid >> 2, wc = wid & 3, fr = lane & 15, fq = lane >> 4;
    const int K = g.K, nt = K / BK;
    unsigned voffA[2], voffB[2];
#pragma unroll
    for (int i = 0; i < 2; ++i) { int R, C; stage_rc(tid * 16 + i * 8192, R, C); const int Rb = Epi::PERM ? ((R & ~31) + perm32(R & 31)) : R;
        voffA[i] = (unsigned)(R * K + C) * 2u; voffB[i] = (unsigned)(Rb * K + C) * 2u; }
    const size_t kstep = (size_t)(BK * 2);
    const size_t hstep = (size_t)HALF * K * 2;
    const size_t tstep = 2 * hstep;
    const unsigned ldsw = (unsigned)wid * 1024u;
    const int aoff = lds_byte(wr * 64 + fr, fq * 8), boff = lds_byte(wc * 32 + fr, fq * 8);
#define PG8_SA(b, h) (((b) * 2 + (h)) * HTB)
#define PG8_SB(b, h) ((4 + (b) * 2 + (h)) * HTB)
#define PG8_STAGE(bufoff, gbase, voff) do { _Pragma("unroll") for (int _i = 0; _i < 2; ++_i) \
        __builtin_amdgcn_global_load_lds((const unsigned*)((const char*)(gbase) + (voff)[_i]), (PG8_LAS unsigned*)(lds + (bufoff) + ldsw + _i * 8192), 16, 0, 0); } while (0)
#define PG8_LDA(dst, b, h) do { _Pragma("unroll") for (int m = 0; m < 4; ++m) _Pragma("unroll") for (int k = 0; k < 2; ++k) dst[m][k] = *(const PG8_LAS bf16x8*)(lds + PG8_SA(b, h) + aoff + m * 2048 + k * 1024); } while (0)
#define PG8_LDB(dst, b, h) do { _Pragma("unroll") for (int n = 0; n < 2; ++n) _Pragma("unroll") for (int k = 0; k < 2; ++k) dst[n][k] = *(const PG8_LAS bf16x8*)(lds + PG8_SB(b, h) + boff + n * 2048 + k * 1024); } while (0)
#define PG8_MMA(ai, bj, At, Bt) do { __builtin_amdgcn_s_setprio(1); _Pragma("unroll") for (int m = 0; m < 4; ++m) _Pragma("unroll") for (int n = 0; n < 2; ++n) _Pragma("unroll") for (int k = 0; k < 2; ++k) \
        acc[ai][bj][m][n] = __builtin_amdgcn_mfma_f32_16x16x32_bf16(Bt[n][k], At[m][k], acc[ai][bj][m][n], 0, 0, 0); __builtin_amdgcn_s_setprio(0); } while (0)
#define PG8_WAIT_V(n) asm volatile("s_waitcnt vmcnt(" #n ")" ::: "memory")
#define PG8_WAIT_L(n) asm volatile("s_waitcnt lgkmcnt(" #n ")" ::: "memory")
#define PG8_BAR __builtin_amdgcn_s_barrier()
#define PG8_SCHED __builtin_amdgcn_sched_barrier(0)
    Unit cur, nxt; int ui = 0;
    if (!S.next(0, cur)) return;
    f32x4 acc[2][2][4][2];
#pragma unroll
    for (int a = 0; a < 2; ++a)
#pragma unroll
        for (int b = 0; b < 2; ++b)
#pragma unroll
            for (int m = 0; m < 4; ++m)
#pragma unroll
                for (int n = 0; n < 2; ++n) acc[a][b][m][n] = (f32x4){0.f, 0.f, 0.f, 0.f};
    bf16x8 At[4][2], B0[2][2], B1[2][2];
    const char* cA = (const char*)g.A + (size_t)cur.pm * tstep; const char* cB = (const char*)g.Bt + (size_t)cur.pn * tstep;
    S.a_ready(cur);
    if constexpr (SP2) {
        PG8_STAGE(PG8_SB(0, 0), cB, voffB); PG8_STAGE(PG8_SB(0, 1), cB + hstep, voffB); PG8_STAGE(PG8_SA(0, 0), cA, voffA); PG8_STAGE(PG8_SA(0, 1), cA + hstep, voffA);
        if (wr == 1) PG8_BAR;
        PG8_WAIT_V(2); PG8_BAR;
        PG8_STAGE(PG8_SB(1, 0), cB + kstep, voffB); PG8_STAGE(PG8_SA(1, 0), cA + kstep, voffA); PG8_STAGE(PG8_SB(1, 1), cB + hstep + kstep, voffB);
        PG8_WAIT_V(6); PG8_BAR;
    } else {
        PG8_STAGE(PG8_SB(0, 0), cB, voffB); PG8_STAGE(PG8_SA(0, 0), cA, voffA); PG8_STAGE(PG8_SB(0, 1), cB + hstep, voffB); PG8_STAGE(PG8_SA(0, 1), cA + hstep, voffA);
        if (wr == 1) PG8_BAR;
        PG8_WAIT_V(4); PG8_BAR;
        PG8_STAGE(PG8_SB(1, 0), cB + kstep, voffB); PG8_STAGE(PG8_SA(1, 0), cA + kstep, voffA); PG8_STAGE(PG8_SB(1, 1), cB + hstep + kstep, voffB);
        PG8_WAIT_V(6); PG8_BAR;
    }
    for (;;) {
        const bool has_next = S.next(ui + 1, nxt);
        const char* nA = has_next ? (const char*)g.A + (size_t)nxt.pm * tstep : cA; const char* nB = has_next ? (const char*)g.Bt + (size_t)nxt.pn * tstep : cB;
        for (int t = 0; t < nt; t += 2) {
            const bool last = (t == nt - 2);
            const char* a1 = cA + (size_t)(t + 1) * kstep;
            const char* a2 = last ? nA : cA + (size_t)(t + 2) * kstep; const char* b2 = last ? nB : cB + (size_t)(t + 2) * kstep;
            const char* a3 = a2 + kstep; const char* b3 = b2 + kstep;
            if (last && has_next) S.a_ready(nxt);
            if constexpr (SP2) {
            PG8_LDB(B0, 0, 0); PG8_LDB(B1, 0, 1); PG8_SCHED; PG8_LDA(At, 0, 0); PG8_STAGE(PG8_SA(1, 1), a1 + hstep, voffA);
            PG8_WAIT_V(8); PG8_WAIT_L(0); PG8_BAR; PG8_MMA(0, 0, At, B0); PG8_MMA(0, 1, At, B1); PG8_BAR; PG8_SCHED;
            PG8_LDA(At, 0, 1); PG8_STAGE(PG8_SB(0, 0), b2, voffB); PG8_STAGE(PG8_SB(0, 1), b2 + hstep, voffB); PG8_STAGE(PG8_SA(0, 0), a2, voffA);
            PG8_WAIT_V(8); PG8_WAIT_L(0); PG8_BAR; PG8_MMA(1, 0, At, B0); PG8_MMA(1, 1, At, B1); PG8_BAR; PG8_SCHED;
            PG8_LDB(B0, 1, 0); PG8_LDB(B1, 1, 1); PG8_SCHED; PG8_LDA(At, 1, 0); PG8_STAGE(PG8_SA(0, 1), a2 + hstep, voffA);
            PG8_WAIT_V(8); PG8_WAIT_L(0); PG8_BAR; PG8_MMA(0, 0, At, B0); PG8_MMA(0, 1, At, B1); PG8_BAR; PG8_SCHED;
            PG8_LDA(At, 1, 1); PG8_STAGE(PG8_SB(1, 0), b3, voffB); PG8_STAGE(PG8_SB(1, 1), b3 + hstep, voffB); PG8_STAGE(PG8_SA(1, 0), a3, voffA);
            PG8_WAIT_V(8); PG8_WAIT_L(0); PG8_BAR; PG8_MMA(1, 0, At, B0); PG8_MMA(1, 1, At, B1); PG8_BAR; PG8_SCHED;
            } else {
            PG8_LDB(B0, 0, 0); PG8_SCHED; PG8_LDA(At, 0, 0); PG8_STAGE(PG8_SA(1, 1), a1 + hstep, voffA);
            PG8_WAIT_L(8); PG8_BAR; PG8_WAIT_L(0); PG8_MMA(0, 0, At, B0); PG8_BAR; PG8_SCHED;
            PG8_LDB(B1, 0, 1); PG8_STAGE(PG8_SB(0, 0), b2, voffB);
            PG8_BAR; PG8_WAIT_L(0); PG8_MMA(0, 1, At, B1); PG8_BAR;
            PG8_LDA(At, 0, 1); PG8_STAGE(PG8_SA(0, 0), a2, voffA);
            PG8_BAR; PG8_WAIT_L(0); PG8_MMA(1, 0, At, B0); PG8_BAR; PG8_SCHED;
            PG8_STAGE(PG8_SB(0, 1), b2 + hstep, voffB);
            PG8_WAIT_V(6); PG8_BAR; PG8_MMA(1, 1, At, B1); PG8_BAR;
            PG8_LDB(B0, 1, 0); PG8_SCHED; PG8_LDA(At, 1, 0); PG8_STAGE(PG8_SA(0, 1), a2 + hstep, voffA);
            PG8_WAIT_L(8); PG8_BAR; PG8_WAIT_L(0); PG8_MMA(0, 0, At, B0); PG8_BAR; PG8_SCHED;
            PG8_LDB(B1, 1, 1); PG8_STAGE(PG8_SB(1, 0), b3, voffB);
            PG8_BAR; PG8_WAIT_L(0); PG8_MMA(0, 1, At, B1); PG8_BAR;
            PG8_LDA(At, 1, 1); PG8_STAGE(PG8_SA(1, 0), a3, voffA);
            PG8_BAR; PG8_WAIT_L(0); PG8_MMA(1, 0, At, B0); PG8_BAR; PG8_SCHED;
            PG8_STAGE(PG8_SB(1, 1), b3 + hstep, voffB);
            PG8_WAIT_V(6); PG8_BAR; PG8_MMA(1, 1, At, B1); PG8_BAR;
            }
        }
        if constexpr (ALIGN_EPI) { if (wr == 0) PG8_BAR; }
        if constexpr (!Epi::AFTER_DRAIN) { E(acc, cur, wr, wc, fr, fq); S.done(cur); }
        if (!has_next) break;
#pragma unroll
        for (int a = 0; a < 2; ++a)
#pragma unroll
            for (int b = 0; b < 2; ++b)
#pragma unroll
                for (int m = 0; m < 4; ++m)
#pragma unroll
                    for (int n = 0; n < 2; ++n) acc[a][b][m][n] = (f32x4){0.f, 0.f, 0.f, 0.f};
        cur = nxt; cA = nA; cB = nB; ++ui;
        if constexpr (ALIGN_EPI) { if (wr == 1) PG8_BAR; }
    }
    PG8_WAIT_V(0);
    if constexpr (!ALIGN_EPI) { if (wr == 0) PG8_BAR; }
    PG8_BAR;
    if constexpr (Epi::AFTER_DRAIN) { E.fused(acc, cur, wr, wc, fr, fq, lds, wid, lane); S.done(cur); }
#undef PG8_SA
#undef PG8_SB
#undef PG8_STAGE
#undef PG8_LDA
#undef PG8_LDB
#undef PG8_MMA
#undef PG8_WAIT_V
#undef PG8_WAIT_L
#undef PG8_BAR
#undef PG8_SCHED
}
}

#ifndef MK_FUSED
#define MK_FUSED 1
#endif
#define GAS __attribute__((address_space(1)))
#define LAS __attribute__((address_space(3)))
typedef unsigned short bf16;
typedef unsigned v4u __attribute__((ext_vector_type(4)));
typedef unsigned v2u __attribute__((ext_vector_type(2)));
typedef float f32x4 __attribute__((ext_vector_type(4)));
typedef float f32x2 __attribute__((ext_vector_type(2)));
typedef float f32x16 __attribute__((ext_vector_type(16)));
typedef short bf16x8 __attribute__((ext_vector_type(8)));
typedef short s16x4 __attribute__((ext_vector_type(4)));
typedef GAS unsigned gu32;

constexpr int NWAVES = 8, NTHR = 512;
constexpr int SEQ = 8192, DM = 2048, NIN = 6144, BR = 512, DEPTH = 2;
constexpr int COL_AB = 0, COL_AC = 512, COL_AX = 1024, COL_AG = 1536, COL_Q = 2048, COL_K = 2560, COL_V = 3072, COL_BG = 3584, COL_CX = 4096, COL_CG = 4608, COL_DU = 5120, COL_DG = 5632;
constexpr float LN_EPS = 1e-5f;
constexpr float ALPHA = 1.41421356237309515f;
constexpr int LRU_LC = 64, LRU_NC = SEQ / LRU_LC;
constexpr int S5_LC = 128, S5_NC = SEQ / S5_LC;
constexpr int ADA_KC = 32;
constexpr size_t MiB = 1u << 20;
constexpr size_t WS_CTL = 0, CTL_ZERO_BYTES = 65536;
constexpr size_t WS_WIN = 2 * MiB;
constexpr size_t WS_WOUT = 50 * MiB;
constexpr size_t WS_WGLU = 66 * MiB;
constexpr size_t WS_LRUW = 67 * MiB;
constexpr size_t WS_S5P = 68 * MiB;
constexpr size_t S5P_LAM1 = 0, S5P_LAML = 16384, S5P_BBT = 65536, S5P_CMT = 262144, S5P_SP8 = 524288, S5P_STRIDE = MiB;
constexpr size_t WS_ADAP = 70 * MiB;
constexpr size_t WS_ADAF = 72 * MiB;
constexpr size_t WS_H = 74 * MiB;
constexpr size_t WS_PROJ = 106 * MiB;
constexpr size_t WS_OG = 202 * MiB;
constexpr size_t WS_LSE = 226 * MiB;
constexpr size_t WS_YG = 227 * MiB;
constexpr size_t WS_LRUC = 235 * MiB;
constexpr size_t WS_S5C = 236 * MiB;
constexpr size_t WS_END = 237 * MiB;
constexpr int CW_BAR = 1024;
constexpr int RING_BYTES = 131072, LDSCTL_OFF = RING_BYTES, MISC_OFF = LDSCTL_OFF + 320, LDS_BYTES = 147456;

#define RLX_AGENT __ATOMIC_RELAXED, __HIP_MEMORY_SCOPE_AGENT
#define LDS_WAIT() asm volatile("s_waitcnt lgkmcnt(0)" ::: "memory")
__device__ __forceinline__ unsigned f2bf(float f) { unsigned u = __builtin_bit_cast(unsigned, f); return (u + 0x7fffu + ((u >> 16) & 1u)) >> 16; }
__device__ __forceinline__ unsigned pk2(float lo, float hi) { return f2bf(lo) | (f2bf(hi) << 16); }
__device__ __forceinline__ float bf2f(unsigned short b) { return __uint_as_float(((unsigned)b) << 16); }
__device__ __forceinline__ float bflo(unsigned w) { return __uint_as_float(w << 16); }
__device__ __forceinline__ float bfhi(unsigned w) { return __uint_as_float(w & 0xffff0000u); }
__device__ __forceinline__ float sigm(float v) { return __builtin_amdgcn_rcpf(1.0f + __expf(-v)); }

#define XB_TMO      128
#define XB_XCNT(j)  (256  + 64 * (j))
#define XB_XSUB(j)  (1280 + 64 * (j))
#define XB_XGEN(j)  (2304 + 64 * (j))
#define XB_TOP      3328
#define XB_TOPGEN   3392
#define XCD_BAR_WORDS 3456
#define XB_SPIN_CAP (1u << 22)
__device__ __forceinline__ unsigned xb_ld(unsigned* p)              { return __hip_atomic_load(p, __ATOMIC_RELAXED, __HIP_MEMORY_SCOPE_AGENT); }
__device__ __forceinline__ unsigned xb_add(unsigned* p, unsigned v) { return __hip_atomic_fetch_add(p, v, __ATOMIC_RELAXED, __HIP_MEMORY_SCOPE_AGENT); }
__device__ __forceinline__ unsigned xb_xcc_id() { return (unsigned)__builtin_amdgcn_s_getreg((3 << 11) | 20) & 0xFu; }
#define XB_SPIN(cond, bar) do { unsigned _sp = 0; while (cond) { __builtin_amdgcn_s_sleep(1); \
    if ((++_sp & 255u) == 0u) { if (xb_ld(&(bar)[XB_TMO])) break; if (_sp > XB_SPIN_CAP) { atomicAdd(&(bar)[XB_TMO], 1u); break; } } } } while (0)
struct XcdBarrier { unsigned* bar; unsigned x; volatile LAS unsigned* st; };
__device__ __forceinline__ XcdBarrier xcd_barrier_post(unsigned* bar, volatile LAS unsigned* st) {
    XcdBarrier b; b.bar = bar; b.x = xb_xcc_id(); b.st = st;
    if (threadIdx.x == 0) (void)xb_add(&bar[XB_XCNT(b.x)], 1u);
    return b;
}
__device__ __forceinline__ void xcd_barrier_complete(unsigned* bar, unsigned x, unsigned& nloc, unsigned& nx) {
    const unsigned G = gridDim.x * gridDim.y * gridDim.z;
    unsigned sum, cnt, mine, sp = 0u;
    for (;;) {
        sum = 0u; cnt = 0u; mine = 0u;
#pragma unroll
        for (unsigned j = 0; j < 16; ++j) { const unsigned c = xb_ld(&bar[XB_XCNT(j)]); sum += c; cnt += (c > 0u) ? 1u : 0u; mine = (j == x) ? c : mine; }
        if (sum == G) break;
        __builtin_amdgcn_s_sleep(1);
        if ((++sp & 255u) == 0u) { if (xb_ld(&bar[XB_TMO])) break; if (sp > XB_SPIN_CAP) { atomicAdd(&bar[XB_TMO], 1u); break; } }
    }
    nloc = mine > 0u ? mine : 1u; nx = cnt > 0u ? cnt : 1u;
}
__device__ __forceinline__ void xcd_barrier(const XcdBarrier& b) {
    asm volatile("s_waitcnt vmcnt(0)" ::: "memory");
    __syncthreads();
    if (threadIdx.x == 0) {
        unsigned* bar = b.bar;
        __builtin_amdgcn_s_waitcnt(0);
        unsigned nloc = b.st[0], nx = b.st[1];
        if (nloc == 0u) { xcd_barrier_complete(bar, b.x, nloc, nx); b.st[0] = nloc; b.st[1] = nx; }
        const unsigned old = xb_add(&bar[XB_XSUB(b.x)], 1u);
        const unsigned gen = old / nloc;
        if (old + 1u == (gen + 1u) * nloc) {
            __builtin_amdgcn_fence(__ATOMIC_RELEASE, "agent");
            asm volatile("s_waitcnt vmcnt(0)" ::: "memory");
            const unsigned og = xb_add(&bar[XB_TOP], 1u);
            const unsigned tg = og / nx;
            if (og + 1u == (tg + 1u) * nx) xb_add(&bar[XB_TOPGEN], 1u);
            else XB_SPIN(xb_ld(&bar[XB_TOPGEN]) == tg, bar);
            __builtin_amdgcn_fence(__ATOMIC_ACQUIRE, "agent");
            xb_add(&bar[XB_XGEN(b.x)], 1u);
            asm volatile("s_waitcnt vmcnt(0)" ::: "memory");
        } else {
            XB_SPIN(xb_ld(&bar[XB_XGEN(b.x)]) == gen, bar);
            __builtin_amdgcn_fence(__ATOMIC_ACQUIRE, "agent");
            asm volatile("s_waitcnt vmcnt(0)" ::: "memory");
        }
    }
    __syncthreads();
}

struct Params { const float* in[27]; float* out; unsigned char* ws; int ph_lo, ph_hi; };
enum { I_X = 0, I_C, I_RELB, I_WADA, I_BADA, I_WIN, I_CONVA, I_CONVC, I_CONVCB, I_LRUWA, I_LRUBA, I_LRUWX, I_LRUBX, I_LRULAM, I_S5LRE, I_S5LIM, I_S5LDT, I_S5BRE, I_S5BIM,
       I_S5CRE, I_S5CIM, I_S5D, I_S5WGLU, I_S5BGLU, I_WOUT, I_LNG, I_LNB };

__device__ __forceinline__ void p0_ada_item(const float* c, const float* w_ada, float* adaP, int item, int lane) {
    const int kc = item & (ADA_KC - 1), rest = item >> 5, cb = rest % 24, l = rest / 24;
    const float* W = w_ada + (size_t)l * DM * NIN + (size_t)(kc * 64) * NIN + cb * 256 + lane * 4;
    f32x4 acc = (f32x4){0.f, 0.f, 0.f, 0.f};
#pragma unroll 8
    for (int k = 0; k < 64; ++k) { const float cv = c[kc * 64 + k]; const float s = cv / (1.0f + expf(-cv)); const f32x4 w = *(const f32x4*)(W + (size_t)k * NIN); acc += w * s; }
    *(f32x4*)(adaP + ((size_t)(kc * 2 + l)) * NIN + cb * 256 + lane * 4) = acc;
}
__device__ __forceinline__ void p0_transpose_item(const float* W, int K, int N, bf16* WT, int row_off, LAS float* scr, int item, int lane) {
    const int nblk = N / 32, kb = item / nblk, nb = item % nblk, k0 = 64 * kb, n0 = 32 * nb;
#pragma unroll 8
    for (int i = 0; i < 32; ++i) { const int kk = 2 * i + (lane >> 5); scr[kk * 33 + (lane & 31)] = W[(size_t)(k0 + kk) * N + n0 + (lane & 31)]; }
    LDS_WAIT(); asm volatile("" ::: "memory");
    const int c = lane & 7;
#pragma unroll
    for (int j = 0; j < 4; ++j) { const int n = (lane >> 3) + 8 * j; const LAS float* s = scr + (8 * c) * 33 + n;
        v4u o; o.x = pk2(s[0 * 33], s[1 * 33]); o.y = pk2(s[2 * 33], s[3 * 33]); o.z = pk2(s[4 * 33], s[5 * 33]); o.w = pk2(s[6 * 33], s[7 * 33]);
        *(GAS v4u*)(WT + (size_t)(row_off + n0 + n) * K + k0 + 8 * c) = o; }
    LDS_WAIT(); asm volatile("" ::: "memory");
}
__device__ __forceinline__ void p0_s5_param(const Params& p, int idx) {
    const int l = idx >> 11, g = (idx >> 6) & 31, pp = idx & 63, lg = l * 32 + g;
    unsigned char* base = p.ws + WS_S5P + (size_t)l * S5P_STRIDE;
    const double dt = exp((double)p.in[I_S5LDT][lg]);
    const double lr = (double)p.in[I_S5LRE][lg * 64 + pp], li = (double)p.in[I_S5LIM][lg * 64 + pp];
    const double mag = exp(lr * dt), th = li * dt; const double ar = mag * cos(th), ai = mag * sin(th);
    const double den = lr * lr + li * li; const double fr = ((ar - 1.0) * lr + ai * li) / den, fi = (ai * lr - (ar - 1.0) * li) / den;
    ((f32x2*)(base + S5P_LAM1))[g * 64 + pp] = (f32x2){(float)ar, (float)ai};
    const double magL = exp(lr * dt * (double)S5_LC), thL = th * (double)S5_LC;
    ((f32x2*)(base + S5P_LAML))[g * 64 + pp] = (f32x2){(float)(magL * cos(thL)), (float)(magL * sin(thL))};
    bf16* bbT = (bf16*)(base + S5P_BBT) + (size_t)g * 128 * 16; bf16* cmT = (bf16*)(base + S5P_CMT) + (size_t)g * 16 * 128;
    const float* bre = p.in[I_S5BRE] + ((size_t)lg * 64 + pp) * 16; const float* bim = p.in[I_S5BIM] + ((size_t)lg * 64 + pp) * 16;
    for (int c = 0; c < 16; ++c) { const double br = bre[c], bi = bim[c];
        bbT[pp * 16 + c] = (bf16)f2bf((float)(fr * br - fi * bi)); bbT[(64 + pp) * 16 + c] = (bf16)f2bf((float)(fr * bi + fi * br)); }
    const float* cre = p.in[I_S5CRE] + (size_t)lg * 16 * 64; const float* cim = p.in[I_S5CIM] + (size_t)lg * 16 * 64;
    for (int c = 0; c < 16; ++c) { cmT[c * 128 + 2 * pp] = (bf16)f2bf(cre[c * 64 + pp]); cmT[c * 128 + 2 * pp + 1] = (bf16)f2bf(-cim[c * 64 + pp]); }
}
__device__ __forceinline__ void phase_p0(const Params& p, LAS unsigned char* lds, int gw, int NGW, int wave, int lane) {
    float* adaP = (float*)(p.ws + WS_ADAP);
    for (int it = gw; it < 2 * 24 * ADA_KC; it += NGW) p0_ada_item(p.in[I_C], p.in[I_WADA], adaP, it, lane);
    LAS float* scr = (LAS float*)(lds + wave * 16384);
    constexpr int I_IN = (DM / 64) * (NIN / 32), I_OUT = (DM / 64) * (DM / 32), I_GLU = (BR / 64) * (BR / 32), I_LRU = 2;
    constexpr int NITEMS = 2 * I_IN + 2 * I_OUT + 2 * I_GLU + 2 * 8 * 2 * I_LRU;
    for (int it = gw; it < NITEMS; it += NGW) {
        int r = it;
        if (r < 2 * I_IN) { const int l = r / I_IN; p0_transpose_item(p.in[I_WIN] + (size_t)l * DM * NIN, DM, NIN, (bf16*)(p.ws + WS_WIN) + (size_t)l * NIN * DM, 0, scr, r % I_IN, lane); continue; } r -= 2 * I_IN;
        if (r < 2 * I_OUT) { const int l = r / I_OUT; p0_transpose_item(p.in[I_WOUT] + (size_t)l * DM * DM, DM, DM, (bf16*)(p.ws + WS_WOUT) + (size_t)l * DM * DM, 0, scr, r % I_OUT, lane); continue; } r -= 2 * I_OUT;
        if (r < 2 * I_GLU) { const int l = r / I_GLU; p0_transpose_item(p.in[I_S5WGLU] + (size_t)l * BR * BR, BR, BR, (bf16*)(p.ws + WS_WGLU) + (size_t)l * BR * BR, 0, scr, r % I_GLU, lane); continue; } r -= 2 * I_GLU;
        { const int item = r & 1, mat = (r >> 1) & 1, lh = r >> 2;
          p0_transpose_item(p.in[mat ? I_LRUWX : I_LRUWA] + (size_t)lh * 64 * 64, 64, 64, (bf16*)(p.ws + WS_LRUW) + (size_t)lh * 128 * 64, mat * 64, scr, item, lane); }
    }
    const int gt = gw * 64 + lane, NGT = NGW * 64;
    for (int i = gt; i < 2 * 32 * 64; i += NGT) p0_s5_param(p, i);
    for (int i = gt; i < 2 * BR; i += NGT) { const int l = i / BR, ch = i % BR; const double lam = (double)p.in[I_LRULAM][i];
        ((float*)(p.ws + WS_S5P + (size_t)l * S5P_STRIDE + S5P_SP8))[ch] = (float)(8.0 * log1p(exp(-lam))); }
}

__device__ __forceinline__ void phase_p1(const Params& p, LAS unsigned char* lds, int bid, int G, int gw, int NGW, int tid, int lane) {
    const float* adaP = (const float*)(p.ws + WS_ADAP); float* adaF = (float*)(p.ws + WS_ADAF);
    LAS float* sv = (LAS float*)lds;
    for (int n = tid; n < 2 * DM; n += NTHR) { float s = p.in[I_BADA][n];
        for (int kc = 0; kc < ADA_KC; ++kc) s += adaP[(size_t)(kc * 2 + 0) * NIN + n];
        sv[n] = (n >= DM) ? 1.0f + s : s; }
    for (int i = bid * NTHR + tid; i < 2 * NIN; i += G * NTHR) { const int l = i / NIN, n = i % NIN; float s = p.in[I_BADA][i];
        for (int kc = 0; kc < ADA_KC; ++kc) s += adaP[(size_t)(kc * 2 + l) * NIN + n];
        adaF[i] = s; }
    __syncthreads();
    const float* x = p.in[I_X]; bf16* h = (bf16*)(p.ws + WS_H);
    for (int row = gw; row < SEQ; row += NGW) {
        const float* xr = x + (size_t)row * DM; bf16* hr = h + (size_t)row * DM;
#pragma unroll
        for (int j = 0; j < 4; ++j) { const int col = j * 512 + lane * 8;
            const f32x4 a = *(const f32x4*)(xr + col), b = *(const f32x4*)(xr + col + 4);
            const f32x4 sa = *(const LAS f32x4*)(sv + col), sb = *(const LAS f32x4*)(sv + col + 4), ca = *(const LAS f32x4*)(sv + DM + col), cb = *(const LAS f32x4*)(sv + DM + col + 4);
            const f32x4 ha = a * ca + sa, hb = b * cb + sb;
            v4u o; o.x = pk2(ha[0], ha[1]); o.y = pk2(ha[2], ha[3]); o.z = pk2(hb[0], hb[1]); o.w = pk2(hb[2], hb[3]);
            *(v4u*)(hr + col) = o; }
    }
}

__device__ __forceinline__ s16x4 vtr(const LAS bf16* pz) { typedef short v4i16_t __attribute__((ext_vector_type(4))); return __builtin_bit_cast(s16x4, __builtin_amdgcn_ds_read_tr16_b64_v4i16((LAS v4i16_t*)pz)); }
__device__ __forceinline__ unsigned cvtpk(float lo, float hi) { typedef __bf16 bf16x2_t __attribute__((ext_vector_type(2))); f32x2 v = {lo, hi}; bf16x2_t b = __builtin_convertvector(v, bf16x2_t); return __builtin_bit_cast(unsigned, b); }
constexpr int ATT_LD = 72;
__device__ __forceinline__ void phase_attn(const Params& p, LAS unsigned char* lds, int bid, int G, int tid, int wave, int lane) {
    LAS bf16* Ks = (LAS bf16*)lds; LAS bf16* Vs = (LAS bf16*)(lds + 256 * ATT_LD * 2); LAS float* biasT = (LAS float*)(lds + 2 * 256 * ATT_LD * 2);
    for (int i = tid; i < 3 * 8 * 129; i += NTHR) { const int grp = i / (8 * 129), rem = i % (8 * 129), hh = rem / 129, d = rem % 129;
        const int dil = grp == 0 ? 1 : (grp == 1 ? 4 : 16); const int dist = d * dil; int bucket;
        if (dist < 16) bucket = dist; else { const float nf = (float)dist; const float v = logf(nf / 16.0f) / 4.852030263919617f * 16.0f; bucket = 16 + (int)v; bucket = bucket < 31 ? bucket : 31; }
        biasT[(grp * 8 + hh) * 132 + d] = p.in[I_RELB][bucket * 8 + hh]; }
    __syncthreads();
    const bf16* proj = (const bf16*)(p.ws + WS_PROJ); bf16* og = (bf16*)(p.ws + WS_OG); float* lse = (float*)(p.ws + WS_LSE);
    const int l15 = lane & 15, g4 = lane >> 4;
    for (int it = bid; it < 1536; it += G) {
        const int grp = it >> 9, rem = it & 511, hh = rem & 7, idx = rem >> 3;
        const int dil = grp == 0 ? 1 : (grp == 1 ? 4 : 16), nbk = 64 / dil, r = idx / nbk, n = idx % nbk;
#pragma unroll
        for (int i = 0; i < 4; ++i) { const int cid = tid + NTHR * i, row = cid >> 3, ch = cid & 7; const int sub = (n - 1) * 128 + row;
            v4u kv = (v4u){0u, 0u, 0u, 0u}, vv = (v4u){0u, 0u, 0u, 0u};
            if (sub >= 0) { const size_t tok = (size_t)sub * dil + r; kv = *(const v4u*)(proj + tok * NIN + COL_K + hh * 64 + ch * 8); vv = *(const v4u*)(proj + tok * NIN + COL_V + hh * 64 + ch * 8); }
            *(LAS v4u*)(Ks + row * ATT_LD + ch * 8) = kv; *(LAS v4u*)(Vs + row * ATT_LD + ch * 8) = vv; }
        __syncthreads();
        const int iq = 16 * wave + l15; const size_t tokq = (size_t)(n * 128 + iq) * dil + r;
        bf16x8 qf[2];
#pragma unroll
        for (int s = 0; s < 2; ++s) qf[s] = *(const bf16x8*)(proj + tokq * NIN + COL_Q + hh * 64 + 32 * s + 8 * g4);
        f32x4 sc[10];
#pragma unroll
        for (int t = 0; t < 10; ++t) { int kt = wave + t; kt = kt < 15 ? kt : 15;
            const bf16x8 a0 = *(const LAS bf16x8*)(Ks + (kt * 16 + l15) * ATT_LD + 8 * g4), a1 = *(const LAS bf16x8*)(Ks + (kt * 16 + l15) * ATT_LD + 32 + 8 * g4);
            f32x4 acc = (f32x4){0.f, 0.f, 0.f, 0.f};
            acc = __builtin_amdgcn_mfma_f32_16x16x32_bf16(a0, qf[0], acc, 0, 0, 0);
            acc = __builtin_amdgcn_mfma_f32_16x16x32_bf16(a1, qf[1], acc, 0, 0, 0);
            sc[t] = acc; }
        const LAS float* bt = biasT + (grp * 8 + hh) * 132;
        float mx = -3.0e38f;
#pragma unroll
        for (int t = 0; t < 10; ++t)
#pragma unroll
            for (int q = 0; q < 4; ++q) { const int delta = l15 + 128 - 16 * t - 4 * g4 - q; const int j = 16 * (wave + t) + 4 * g4 + q;
                const bool valid = (delta >= 0) & (delta <= 128) & ((n > 0) | (j >= 128));
                const int dc = delta < 0 ? 0 : (delta > 128 ? 128 : delta);
                const float v = valid ? sc[t][q] * 0.125f + bt[dc] : -1.0e30f; sc[t][q] = v; mx = fmaxf(mx, v); }
        mx = fmaxf(mx, __shfl_xor(mx, 16)); mx = fmaxf(mx, __shfl_xor(mx, 32));
        float ls = 0.f;
#pragma unroll
        for (int t = 0; t < 10; ++t)
#pragma unroll
            for (int q = 0; q < 4; ++q) { const float e = __expf(sc[t][q] - mx); sc[t][q] = e; ls += e; }
        ls += __shfl_xor(ls, 16); ls += __shfl_xor(ls, 32);
        f32x4 o[4];
#pragma unroll
        for (int d0 = 0; d0 < 4; ++d0) o[d0] = (f32x4){0.f, 0.f, 0.f, 0.f};
        const int vq = l15 >> 2, vp = lane & 3;
#pragma unroll
        for (int pp = 0; pp < 5; ++pp) { const int ta = 2 * pp, tb = 2 * pp + 1; int ka = wave + ta, kb = wave + tb; ka = ka < 15 ? ka : 15; kb = kb < 15 ? kb : 15;
            v4u pw; pw.x = cvtpk(sc[ta][0], sc[ta][1]); pw.y = cvtpk(sc[ta][2], sc[ta][3]); pw.z = cvtpk(sc[tb][0], sc[tb][1]); pw.w = cvtpk(sc[tb][2], sc[tb][3]);
            const bf16x8 pf = __builtin_bit_cast(bf16x8, pw);
#pragma unroll
            for (int d0 = 0; d0 < 4; ++d0) { const s16x4 lo = vtr(Vs + (ka * 16 + 4 * g4 + vq) * ATT_LD + d0 * 16 + 4 * vp), hi = vtr(Vs + (kb * 16 + 4 * g4 + vq) * ATT_LD + d0 * 16 + 4 * vp);
                const bf16x8 vf = (bf16x8){lo[0], lo[1], lo[2], lo[3], hi[0], hi[1], hi[2], hi[3]};
                o[d0] = __builtin_amdgcn_mfma_f32_16x16x32_bf16(vf, pf, o[d0], 0, 0, 0); } }
        const float inv = 1.0f / ls;
        bf16* orow = og + ((size_t)grp * SEQ + tokq) * BR + hh * 64 + 4 * g4;
#pragma unroll
        for (int d0 = 0; d0 < 4; ++d0) { v2u w; w.x = pk2(o[d0][0] * inv, o[d0][1] * inv); w.y = pk2(o[d0][2] * inv, o[d0][3] * inv); *(v2u*)(orow + d0 * 16) = w; }
        if (g4 == 0) lse[((size_t)grp * SEQ + tokq) * 8 + hh] = mx + logf(ls);
        __syncthreads();
    }
}

__device__ __forceinline__ void phase_mixa(const Params& p, int l, int bid, int G, int tid) {
    const bf16* proj = (const bf16*)(p.ws + WS_PROJ); bf16* cat = (bf16*)(p.ws + WS_H);
    const int co = (tid & 63) * 8, tq = tid >> 6;
    float w[3][8];
#pragma unroll
    for (int j = 0; j < 3; ++j)
#pragma unroll
        for (int e = 0; e < 8; ++e) w[j][e] = p.in[I_CONVA][((size_t)l * 3 + j) * BR + co + e];
    for (int it = bid; it < SEQ / 32; it += G) {
        const int tb = it * 32 + tq * 4;
        float pr[6][8];
#pragma unroll
        for (int k = 0; k < 6; ++k) { const int tok = tb - 2 + k;
            if (tok >= 0) { const v4u a = *(const v4u*)(proj + (size_t)tok * NIN + COL_AC + co), b = *(const v4u*)(proj + (size_t)tok * NIN + COL_AX + co);
                pr[k][0] = bflo(a.x) * bflo(b.x); pr[k][1] = bfhi(a.x) * bfhi(b.x); pr[k][2] = bflo(a.y) * bflo(b.y); pr[k][3] = bfhi(a.y) * bfhi(b.y);
                pr[k][4] = bflo(a.z) * bflo(b.z); pr[k][5] = bfhi(a.z) * bfhi(b.z); pr[k][6] = bflo(a.w) * bflo(b.w); pr[k][7] = bfhi(a.w) * bfhi(b.w); }
            else {
#pragma unroll
                for (int e = 0; e < 8; ++e) pr[k][e] = 0.f; } }
#pragma unroll
        for (int k = 0; k < 4; ++k) { const size_t tok = (size_t)(tb + k);
            const v4u ab = *(const v4u*)(proj + tok * NIN + COL_AB + co), ag = *(const v4u*)(proj + tok * NIN + COL_AG + co);
            float y[8];
#pragma unroll
            for (int e = 0; e < 8; ++e) y[e] = w[0][e] * pr[k][e] + w[1][e] * pr[k + 1][e] + w[2][e] * pr[k + 2][e];
            v4u o;
            o.x = pk2(y[0] * bflo(ab.x) * bflo(ag.x), y[1] * bfhi(ab.x) * bfhi(ag.x)); o.y = pk2(y[2] * bflo(ab.y) * bflo(ag.y), y[3] * bfhi(ab.y) * bfhi(ag.y));
            o.z = pk2(y[4] * bflo(ab.z) * bflo(ag.z), y[5] * bfhi(ab.z) * bfhi(ag.z)); o.w = pk2(y[6] * bflo(ab.w) * bflo(ag.w), y[7] * bfhi(ab.w) * bfhi(ag.w));
            *(v4u*)(cat + tok * DM + co) = o; }
    }
}
__device__ __forceinline__ void phase_attn_combine(const Params& p, int bid, int G, int tid) {
    const bf16* proj = (const bf16*)(p.ws + WS_PROJ); bf16* cat = (bf16*)(p.ws + WS_H); const bf16* og = (const bf16*)(p.ws + WS_OG); const float* lse = (const float*)(p.ws + WS_LSE);
    for (int it = bid; it < SEQ / 32; it += G) {
#pragma unroll
        for (int i = 0; i < 4; ++i) { const int pair = tid + NTHR * i; const size_t tok = (size_t)it * 32 + (pair >> 6); const int oc = pair & 63, hh = oc >> 3;
            const float l0 = lse[(0 * (size_t)SEQ + tok) * 8 + hh], l1 = lse[(1 * (size_t)SEQ + tok) * 8 + hh], l2 = lse[(2 * (size_t)SEQ + tok) * 8 + hh];
            const float m = fmaxf(l0, fmaxf(l1, l2)); float w0 = __expf(l0 - m), w1 = __expf(l1 - m), w2 = __expf(l2 - m); const float inv = 1.0f / (w0 + w1 + w2); w0 *= inv; w1 *= inv; w2 *= inv;
            const v4u a = *(const v4u*)(og + (0 * (size_t)SEQ + tok) * BR + oc * 8), b = *(const v4u*)(og + (1 * (size_t)SEQ + tok) * BR + oc * 8), c = *(const v4u*)(og + (2 * (size_t)SEQ + tok) * BR + oc * 8);
            const v4u gt = *(const v4u*)(proj + tok * NIN + COL_BG + oc * 8);
            v4u o;
            o.x = pk2((w0 * bflo(a.x) + w1 * bflo(b.x) + w2 * bflo(c.x)) * bflo(gt.x), (w0 * bfhi(a.x) + w1 * bfhi(b.x) + w2 * bfhi(c.x)) * bfhi(gt.x));
            o.y = pk2((w0 * bflo(a.y) + w1 * bflo(b.y) + w2 * bflo(c.y)) * bflo(gt.y), (w0 * bfhi(a.y) + w1 * bfhi(b.y) + w2 * bfhi(c.y)) * bfhi(gt.y));
            o.z = pk2((w0 * bflo(a.z) + w1 * bflo(b.z) + w2 * bflo(c.z)) * bflo(gt.z), (w0 * bfhi(a.z) + w1 * bfhi(b.z) + w2 * bfhi(c.z)) * bfhi(gt.z));
            o.w = pk2((w0 * bflo(a.w) + w1 * bflo(b.w) + w2 * bflo(c.w)) * bflo(gt.w), (w0 * bfhi(a.w) + w1 * bfhi(b.w) + w2 * bfhi(c.w)) * bfhi(gt.w));
            *(v4u*)(cat + tok * DM + BR + oc * 8) = o; }
    }
}

constexpr int LRU_XB_LD = 72;
constexpr int LRU_WAVE_LDS = 32 * 64 * 4 + 32 * LRU_XB_LD * 2;
template <bool PASS2>
__device__ __forceinline__ void lru_item(const Params& p, int l, LAS unsigned char* wl, int c, int hd, int lane) {
    LAS float* xcf = (LAS float*)wl; LAS bf16* xcb = (LAS bf16*)(wl + 32 * 64 * 4);
    const bf16* proj = (const bf16*)(p.ws + WS_PROJ); bf16* cat = (bf16*)(p.ws + WS_H);
    float* lruA = (float*)(p.ws + WS_LRUC); float* lruH = lruA + LRU_NC * BR;
    const bf16* wT = (const bf16*)(p.ws + WS_LRUW) + (size_t)(l * 8 + hd) * 128 * 64;
    const float* sp8 = (const float*)(p.ws + WS_S5P + (size_t)l * S5P_STRIDE + S5P_SP8);
    const int s = lane & 31, hf = lane >> 5, chl = hd * 64 + lane;
    float cw[4];
#pragma unroll
    for (int j = 0; j < 4; ++j) cw[j] = p.in[I_CONVC][((size_t)l * 4 + j) * BR + chl];
    const float cbias = p.in[I_CONVCB][(size_t)l * BR + chl];
    float ba[2], bx[2], sp[2], H[2], Ap[2];
#pragma unroll
    for (int e = 0; e < 2; ++e) { const int ch = hd * 64 + s + 32 * e; ba[e] = p.in[I_LRUBA][(size_t)l * BR + ch]; bx[e] = p.in[I_LRUBX][(size_t)l * BR + ch]; sp[e] = sp8[ch]; H[e] = 0.f; Ap[e] = 1.f; }
    if (PASS2) {
#pragma unroll
        for (int e = 0; e < 2; ++e) { const int ch = hd * 64 + s + 32 * e; float h = 0.f;
#pragma unroll 8
            for (int cc = 0; cc < c; ++cc) h = lruA[(size_t)cc * BR + ch] * h + lruH[(size_t)cc * BR + ch];
            H[e] = h; }
    }
    const int t00 = c * LRU_LC;
    float xm3 = 0.f, xm2 = 0.f, xm1 = 0.f;
    if (t00 > 0) { xm3 = bf2f(proj[(size_t)(t00 - 3) * NIN + COL_CX + chl]); xm2 = bf2f(proj[(size_t)(t00 - 2) * NIN + COL_CX + chl]); xm1 = bf2f(proj[(size_t)(t00 - 1) * NIN + COL_CX + chl]); }
    for (int tile = 0; tile < LRU_LC / 32; ++tile) {
        const int t0 = t00 + tile * 32;
#pragma unroll 8
        for (int t = 0; t < 32; ++t) { const float xv = bf2f(proj[(size_t)(t0 + t) * NIN + COL_CX + chl]);
            const float xc = cw[0] * xm3 + cw[1] * xm2 + cw[2] * xm1 + cw[3] * xv + cbias; xm3 = xm2; xm2 = xm1; xm1 = xv;
            xcf[t * 64 + lane] = xc; xcb[t * LRU_XB_LD + lane] = (bf16)f2bf(xc); }
        LDS_WAIT(); asm volatile("" ::: "memory");
        bf16x8 af[4];
#pragma unroll
        for (int ks = 0; ks < 4; ++ks) af[ks] = *(const LAS bf16x8*)(xcb + s * LRU_XB_LD + ks * 16 + 8 * hf);
#pragma unroll
        for (int e = 0; e < 2; ++e) {
            f32x16 accr, acci;
#pragma unroll
            for (int q = 0; q < 16; ++q) { accr[q] = 0.f; acci[q] = 0.f; }
#pragma unroll
            for (int ks = 0; ks < 4; ++ks) { const bf16x8 br = *(const bf16x8*)(wT + (size_t)(32 * e + s) * 64 + ks * 16 + 8 * hf), bi = *(const bf16x8*)(wT + (size_t)(64 + 32 * e + s) * 64 + ks * 16 + 8 * hf);
                accr = __builtin_amdgcn_mfma_f32_32x32x16_bf16(af[ks], br, accr, 0, 0, 0); acci = __builtin_amdgcn_mfma_f32_32x32x16_bf16(af[ks], bi, acci, 0, 0, 0); }
            float av[16], bv[16];
#pragma unroll
            for (int q = 0; q < 16; ++q) { const int tt = (q & 3) + 8 * (q >> 2) + 4 * hf;
                const float rg = sigm(accr[q] + ba[e]), ig = sigm(acci[q] + bx[e]);
                const float la = -rg * sp[e]; const float a = __expf(la); const float z = 2.0f * la;
                const float em = z * (1.0f + z * (1.0f / 2.0f) * (1.0f + z * (1.0f / 3.0f) * (1.0f + z * 0.25f * (1.0f + z * 0.2f * (1.0f + z * (1.0f / 6.0f) * (1.0f + z * (1.0f / 7.0f)))))));
                const float one_m = (z > -0.3f) ? -em : (1.0f - __expf(z));
                av[q] = a; bv[q] = sqrtf(one_m) * ig * xcf[tt * 64 + s + 32 * e]; }
            float h = H[e];
#pragma unroll
            for (int j = 0; j < 4; ++j) {
                float e0 = h;
#pragma unroll
                for (int q = 0; q < 4; ++q) e0 = av[4 * j + q] * e0 + bv[4 * j + q];
                const float e0o = __shfl_xor(e0, 32);
                float xs = hf ? e0o : h;
#pragma unroll
                for (int q = 0; q < 4; ++q) { xs = av[4 * j + q] * xs + bv[4 * j + q]; bv[4 * j + q] = xs; }
                const float xo = __shfl_xor(xs, 32);
                h = hf ? xs : xo;
            }
            H[e] = h;
            if (!PASS2) { float pa = 1.f;
#pragma unroll
                for (int q = 0; q < 16; ++q) pa *= av[q];
                pa *= __shfl_xor(pa, 32); Ap[e] *= pa; }
            else {
#pragma unroll
                for (int q = 0; q < 16; ++q) { const int tt = (q & 3) + 8 * (q >> 2) + 4 * hf; const size_t tok = (size_t)(t0 + tt); const int ch = hd * 64 + s + 32 * e;
                    const float gsv = bf2f(proj[tok * NIN + COL_CG + ch]);
                    cat[tok * DM + 2 * BR + ch] = (bf16)f2bf(bv[q] * gsv); } }
        }
        LDS_WAIT(); asm volatile("" ::: "memory");
    }
    if (!PASS2 && hf == 0) {
#pragma unroll
        for (int e = 0; e < 2; ++e) { const int ch = hd * 64 + s + 32 * e; lruA[(size_t)c * BR + ch] = Ap[e]; lruH[(size_t)c * BR + ch] = H[e]; } }
}

constexpr int S5_X_LD = 136;
constexpr int S5_WAVE_LDS = 32 * S5_X_LD * 2;
template <bool PASS2>
__device__ __forceinline__ void s5_item(const Params& p, int l, LAS unsigned char* wl, int c, int g, int lane) {
    LAS bf16* Xt = (LAS bf16*)wl;
    const bf16* proj = (const bf16*)(p.ws + WS_PROJ); bf16* yg = (bf16*)(p.ws + WS_YG); float* s5x = (float*)(p.ws + WS_S5C);
    const unsigned char* pb = p.ws + WS_S5P + (size_t)l * S5P_STRIDE;
    const f32x2* lam1 = (const f32x2*)(pb + S5P_LAM1) + g * 64; const f32x2* lamL = (const f32x2*)(pb + S5P_LAML) + g * 64;
    const bf16* bbT = (const bf16*)(pb + S5P_BBT) + (size_t)g * 128 * 16; const bf16* cmT = (const bf16*)(pb + S5P_CMT) + (size_t)g * 16 * 128;
    const int s = lane & 31, hf = lane >> 5, l15 = lane & 15, g4 = lane >> 4;
    bf16x8 bb[4];
#pragma unroll
    for (int nb = 0; nb < 4; ++nb) bb[nb] = *(const bf16x8*)(bbT + (size_t)(nb * 32 + s) * 16 + 8 * hf);
    float lr[2], li[2], xr[2], xi[2];
#pragma unroll
    for (int e = 0; e < 2; ++e) { const f32x2 v = lam1[s + 32 * e]; lr[e] = v.x; li[e] = v.y; xr[e] = 0.f; xi[e] = 0.f; }
    if (PASS2) {
#pragma unroll
        for (int e = 0; e < 2; ++e) { const f32x2 v = lamL[s + 32 * e]; const float ar = v.x, ai = v.y; float hr = 0.f, hi = 0.f; const int pidx = s + 32 * e;
#pragma unroll 8
            for (int cc = 0; cc < c; ++cc) { const float ur = s5x[((size_t)cc * 32 + g) * 128 + pidx], ui = s5x[((size_t)cc * 32 + g) * 128 + 64 + pidx];
                const float nr = ar * hr - ai * hi + ur, ni = ar * hi + ai * hr + ui; hr = nr; hi = ni; }
            xr[e] = hr; xi[e] = hi; }
    }
    bf16x8 cm[4]; float dsk = 0.f;
    if (PASS2) {
#pragma unroll
        for (int ks = 0; ks < 4; ++ks) cm[ks] = *(const bf16x8*)(cmT + (size_t)l15 * 128 + ks * 32 + 8 * g4);
        dsk = p.in[I_S5D][(size_t)l * BR + g * 16 + l15];
    }
    for (int tile = 0; tile < S5_LC / 32; ++tile) {
        const int t0 = c * S5_LC + tile * 32;
        const bf16x8 uf = *(const bf16x8*)(proj + (size_t)(t0 + s) * NIN + COL_DU + g * 16 + 8 * hf);
        f32x16 zero16;
#pragma unroll
        for (int q = 0; q < 16; ++q) zero16[q] = 0.f;
#pragma unroll
        for (int e = 0; e < 2; ++e) {
            f32x16 br = __builtin_amdgcn_mfma_f32_32x32x16_bf16(uf, bb[e], zero16, 0, 0, 0);
            f32x16 bi = __builtin_amdgcn_mfma_f32_32x32x16_bf16(uf, bb[2 + e], zero16, 0, 0, 0);
            float hr = xr[e], hi = xi[e]; const float ar = lr[e], ai = li[e];
#pragma unroll
            for (int j = 0; j < 4; ++j) {
                float er = hr, ei = hi;
#pragma unroll
                for (int q = 0; q < 4; ++q) { const float nr = ar * er - ai * ei + br[4 * j + q], ni = ar * ei + ai * er + bi[4 * j + q]; er = nr; ei = ni; }
                const float ero = __shfl_xor(er, 32), eio = __shfl_xor(ei, 32);
                float sr = hf ? ero : hr, si = hf ? eio : hi;
#pragma unroll
                for (int q = 0; q < 4; ++q) { const float nr = ar * sr - ai * si + br[4 * j + q], ni = ar * si + ai * sr + bi[4 * j + q]; sr = nr; si = ni;
                    if (PASS2) { const int tt = q + 8 * j + 4 * hf; *(LAS unsigned*)(Xt + tt * S5_X_LD + 2 * (s + 32 * e)) = pk2(sr, si); } }
                const float sro = __shfl_xor(sr, 32), sio = __shfl_xor(si, 32);
                hr = hf ? sr : sro; hi = hf ? si : sio;
            }
            xr[e] = hr; xi[e] = hi;
        }
        if (PASS2) {
            LDS_WAIT(); asm volatile("" ::: "memory");
#pragma unroll
            for (int rt = 0; rt < 2; ++rt) {
                f32x4 acc = (f32x4){0.f, 0.f, 0.f, 0.f};
#pragma unroll
                for (int ks = 0; ks < 4; ++ks) { const bf16x8 a = *(const LAS bf16x8*)(Xt + (rt * 16 + l15) * S5_X_LD + ks * 32 + 8 * g4);
                    acc = __builtin_amdgcn_mfma_f32_16x16x32_bf16(a, cm[ks], acc, 0, 0, 0); }
#pragma unroll
                for (int q = 0; q < 4; ++q) { const size_t tok = (size_t)(t0 + rt * 16 + 4 * g4 + q); const float u = bf2f(proj[tok * NIN + COL_DU + g * 16 + l15]);
                    const float y = acc[q] + dsk * u; const float yy = y * sigm(1.5957691216057308f * (y + 0.044715f * y * y * y));
                    yg[tok * BR + g * 16 + l15] = (bf16)f2bf(yy); }
            }
            LDS_WAIT(); asm volatile("" ::: "memory");
        }
    }
    if (!PASS2 && hf == 0) {
#pragma unroll
        for (int e = 0; e < 2; ++e) { s5x[((size_t)c * 32 + g) * 128 + s + 32 * e] = xr[e]; s5x[((size_t)c * 32 + g) * 128 + 64 + s + 32 * e] = xi[e]; } }
}

__device__ __forceinline__ void phase_ln(const Params& p, int l, int gw, int NGW, int lane) {
    float* z = p.out; bf16* h = (bf16*)(p.ws + WS_H); const float* lg = p.in[I_LNG] + (size_t)l * DM; const float* lb = p.in[I_LNB] + (size_t)l * DM;
    const float* adaF = (const float*)(p.ws + WS_ADAF) + (size_t)(l + 1 < DEPTH ? l + 1 : l) * NIN;
    for (int row = gw; row < SEQ; row += NGW) {
        float* zr = z + (size_t)row * DM + 4 * lane;
        f32x4 v[8]; float s = 0.f;
#pragma unroll
        for (int j = 0; j < 8; ++j) { v[j] = *(const f32x4*)(zr + 256 * j); s += (v[j][0] + v[j][1]) + (v[j][2] + v[j][3]); }
#pragma unroll
        for (int o = 1; o < 64; o <<= 1) s += __shfl_xor(s, o);
        const float mean = s * (1.0f / DM); float q = 0.f;
#pragma unroll
        for (int j = 0; j < 8; ++j) { v[j] = v[j] - mean; q += (v[j][0] * v[j][0] + v[j][1] * v[j][1]) + (v[j][2] * v[j][2] + v[j][3] * v[j][3]); }
#pragma unroll
        for (int o = 1; o < 64; o <<= 1) q += __shfl_xor(q, o);
        const float rstd = 1.0f / sqrtf(q * (1.0f / DM) + LN_EPS);
#pragma unroll
        for (int j = 0; j < 8; ++j) { const int col = 4 * lane + 256 * j; const f32x4 gg = *(const f32x4*)(lg + col), bb = *(const f32x4*)(lb + col);
            const f32x4 o = v[j] * rstd * gg + bb; *(f32x4*)(zr + 256 * j) = o;
            if (l + 1 < DEPTH) { const f32x4 sh = *(const f32x4*)(adaF + col), sc = *(const f32x4*)(adaF + DM + col); const f32x4 hv = o * (sc + 1.0f) + sh;
                v2u w; w.x = pk2(hv[0], hv[1]); w.y = pk2(hv[2], hv[3]); *(v2u*)(h + (size_t)row * DM + col) = w; } }
    }
}

constexpr int NPHASE = 2 + 6 * DEPTH;
__global__ void __launch_bounds__(NTHR, 2) mk_fwd(Params p_) {
    extern __shared__ __attribute__((aligned(16))) unsigned char lds_raw[];
    LAS unsigned char* lds = (LAS unsigned char*)lds_raw;
    const int G = gridDim.x, bid = blockIdx.x;
    const int vcu = (G % 8 == 0) ? (bid % 8) * (G / 8) + bid / 8 : bid;
    const int NGW = G * NWAVES;
    volatile LAS unsigned* MISC = (volatile LAS unsigned*)(lds + MISC_OFF);
    for (int u = threadIdx.x; u < (LDS_BYTES - LDSCTL_OFF) / 4; u += NTHR) ((LAS unsigned*)(lds + LDSCTL_OFF))[u] = 0u;
#define IDS() int tid = threadIdx.x; asm volatile("" : "+v"(tid)); const int lane = tid & 63, wave = __builtin_amdgcn_readfirstlane(tid >> 6), gw = vcu * NWAVES + wave; (void)lane; (void)gw; \
              Params p = p_; { unsigned long long z_ = 0; asm volatile("" : "+s"(z_)); p.ws = p_.ws + z_; }
    __syncthreads();
    XcdBarrier bar; bar.bar = (unsigned*)(p_.ws + WS_CTL) + CW_BAR; bar.x = 0; bar.st = nullptr;
    const int lo = p_.ph_lo, hi = p_.ph_hi;
    if (hi - lo > 1) bar = xcd_barrier_post((unsigned*)(p_.ws + WS_CTL) + CW_BAR, MISC + 8);
#ifndef PHMASK
#define PHMASK 0x1FFF
#endif
#define EN(t) (((PHMASK) >> (t)) & 1)
#define IN(k) (lo <= (k) && (k) < hi)
#define SEAM(k) do { if (IN(k) && IN((k) + 1)) xcd_barrier(bar); } while (0)
    if (EN(0) && IN(0)) { IDS(); phase_p0(p, lds, gw, NGW, wave, lane); } SEAM(0);
    if (EN(1) && IN(1)) { IDS(); phase_p1(p, lds, vcu, G, gw, NGW, tid, lane); } SEAM(1);
#pragma unroll
    for (int l = 0; l < DEPTH; ++l) {
        const int pb = 2 + 6 * l;
        if (EN(2) && IN(pb + 0)) { IDS();
            pg8::Gemm g{(const pg8::bf16_t*)(p.ws + WS_H), (const pg8::bf16_t*)(p.ws + WS_WIN) + (size_t)l * NIN * DM, SEQ, NIN, DM}; pg8::StaticOrder S; S.init(SEQ, NIN, G, bid);
            pg8::EpiProj E{(pg8::bf16_t*)(p.ws + WS_PROJ), NIN};
            pg8::gemm_phase<pg8::EpiProj, pg8::StaticOrder, true, true>(lds, g, S, E);
        } SEAM(pb + 0);
        if (IN(pb + 1)) { IDS();
            if (EN(3)) phase_attn(p, lds, vcu, G, tid, wave, lane);
            __syncthreads();
            if (EN(4)) for (int it = gw; it < LRU_NC * 8; it += NGW) lru_item<false>(p, l, lds + wave * LRU_WAVE_LDS, it >> 3, it & 7, lane);
            __syncthreads();
            if (EN(5)) for (int it = gw; it < S5_NC * 32; it += NGW) s5_item<false>(p, l, lds + wave * S5_WAVE_LDS, it >> 5, it & 31, lane);
            if (EN(6)) phase_mixa(p, l, vcu, G, tid);
        } SEAM(pb + 1);
        if (IN(pb + 2)) { IDS();
            if (EN(7)) for (int it = gw; it < S5_NC * 32; it += NGW) s5_item<true>(p, l, lds + wave * S5_WAVE_LDS, it >> 5, it & 31, lane);
            __syncthreads();
            if (EN(8)) for (int it = gw; it < LRU_NC * 8; it += NGW) lru_item<true>(p, l, lds + wave * LRU_WAVE_LDS, it >> 3, it & 7, lane);
            if (EN(9)) phase_attn_combine(p, vcu, G, tid);
        } SEAM(pb + 2);
        if (EN(10) && IN(pb + 3)) { IDS();
            __syncthreads();
            pg8::Gemm g{(const pg8::bf16_t*)(p.ws + WS_YG), (const pg8::bf16_t*)(p.ws + WS_WGLU) + (size_t)l * BR * BR, SEQ, BR, BR}; pg8::StaticOrder S; S.init(SEQ, BR, G, bid);
            pg8::EpiGlu E{(pg8::bf16_t*)(p.ws + WS_H) + 3 * BR, DM, (const pg8::bf16_t*)(p.ws + WS_YG), BR, (const pg8::bf16_t*)(p.ws + WS_PROJ) + COL_DG, NIN, p.in[I_S5BGLU] + (size_t)l * BR};
            pg8::gemm_phase<pg8::EpiGlu, pg8::StaticOrder, true, true>(lds, g, S, E);
        } SEAM(pb + 3);
        if (EN(11) && IN(pb + 4)) { IDS();
            pg8::Gemm g{(const pg8::bf16_t*)(p.ws + WS_H), (const pg8::bf16_t*)(p.ws + WS_WOUT) + (size_t)l * DM * DM, SEQ, DM, DM}; pg8::StaticOrder S; S.init(SEQ, DM, G, bid);
            pg8::EpiRes E{l == 0 ? p.in[I_X] : p.out, p.out, DM, (const float*)(p.ws + WS_ADAF) + (size_t)l * NIN + 2 * DM, ALPHA};
            pg8::gemm_phase<pg8::EpiRes, pg8::StaticOrder, true, true>(lds, g, S, E);
        } SEAM(pb + 4);
        if (EN(12) && IN(pb + 5)) { IDS(); phase_ln(p, l, gw, NGW, lane); } SEAM(pb + 5);
    }
#undef IN
#undef EN
#undef IDS
#undef SEAM
}

extern "C" void kernel_launch(void* const* d_in, const int* in_sizes, int n_in, void* d_out, int out_size, void* d_ws, size_t ws_size, hipStream_t stream) {
    static int grid = 0;
    if (grid == 0) {
        if (n_in != 27 || out_size != SEQ * DM || ws_size < WS_END) { fprintf(stderr, "kernel_launch: unexpected problem (n_in %d, out %d, ws %zu); nothing launched\n", n_in, out_size, ws_size); grid = -1; return; }
        int dev = 0, cus = 0, per_cu = 0;
        if (hipGetDevice(&dev) != hipSuccess || hipDeviceGetAttribute(&cus, hipDeviceAttributeMultiprocessorCount, dev) != hipSuccess) { grid = -1; return; }
        if (hipFuncSetAttribute((const void*)mk_fwd, hipFuncAttributeMaxDynamicSharedMemorySize, LDS_BYTES) != hipSuccess) { fprintf(stderr, "kernel_launch: hipFuncSetAttribute failed\n"); grid = -1; return; }
        if (hipOccupancyMaxActiveBlocksPerMultiprocessor(&per_cu, (const void*)mk_fwd, NTHR, LDS_BYTES) != hipSuccess || per_cu < 1) { fprintf(stderr, "kernel_launch: occupancy query says %d blocks per CU\n", per_cu); }
        (void)hipGetLastError();
        grid = cus;
    }
    if (grid < 0) return;
    (void)hipMemsetAsync((char*)d_ws + WS_CTL, 0, CTL_ZERO_BYTES, stream);
    Params a{};
    for (int i = 0; i < 27; ++i) a.in[i] = (const float*)d_in[i];
    a.out = (float*)d_out; a.ws = (unsigned char*)d_ws;
#if MK_FUSED
    a.ph_lo = 0; a.ph_hi = NPHASE;
    hipLaunchKernelGGL(mk_fwd, dim3(grid), dim3(NTHR), LDS_BYTES, stream, a);
#else
    for (int k = 0; k < NPHASE; ++k) { a.ph_lo = k; a.ph_hi = k + 1; hipLaunchKernelGGL(mk_fwd, dim3(grid), dim3(NTHR), LDS_BYTES, stream, a); }
#endif
}
```

```cpp
#include <hip/hip_runtime.h>
#include <cstdio>
#include <cstdint>
namespace pg8 {
#define PG8_LAS __attribute__((address_space(3)))
typedef unsigned short bf16_t;
typedef short bf16x8 __attribute__((ext_vector_type(8)));
typedef float f32x4 __attribute__((ext_vector_type(4)));
typedef unsigned u32x4 __attribute__((ext_vector_type(4)));
constexpr int BM = 256, BK = 64, HALF = 128, HTB = HALF * BK * 2  , STAGE_BYTES = 8 * HTB, NXCD = 8, WGM = 8;

__host__ __device__ __forceinline__ int lds_byte(int r, int c) { const int st = (r >> 4) * 2 + (c >> 5), rr = r & 15, cc = c & 31, ob = rr * 64 + cc * 2; return st * 1024 + (ob ^ (((ob >> 9) & 1) << 5)); }
__host__ __device__ __forceinline__ void stage_rc(int b, int& R, int& C) { const int st = b / 1024, sb = b % 1024, swz = sb ^ (((sb >> 9) & 1) << 5); R = (st >> 1) * 16 + swz / 64; C = (st & 1) * 32 + (swz % 64) / 2; }
__host__ __device__ __forceinline__ int perm32(int rho) { const int n = rho >> 4, i = rho & 15; return 8 * (i >> 2) + 4 * n + (i & 3); }

struct Unit { int pm, pn; };
struct Gemm { const bf16_t* A; const bf16_t* Bt; int M, N, K; };

struct StaticOrder {
    int nM, nN, nwg, G, c;
    __host__ __device__ void init(int M, int N, int G_, int c_) { nM = M / BM; nN = N / BM; nwg = nM * nN; G = G_; c = c_; }
    __host__ __device__ bool next(int i, Unit& u) const {
        const long L = (long)i * G + c; if (L >= nwg) return false;
        int wgid = (int)L; { const int q = nwg / NXCD, r = nwg % NXCD, xcd = wgid % NXCD, off = wgid / NXCD; wgid = (xcd < r ? xcd * (q + 1) : r * (q + 1) + (xcd - r) * q) + off; }
        const int nig = WGM * nN, gid = wgid / nig, fm = gid * WGM, gsz = (nM - fm) < WGM ? (nM - fm) : WGM;
        u.pm = fm + ((wgid % nig) % gsz); u.pn = (wgid % nig) / gsz; return true;
    }
    __device__ __forceinline__ void a_ready(const Unit&) const {}
    __device__ __forceinline__ void done(const Unit&) const {}
};

__device__ __forceinline__ unsigned cvt_pk_bf16(float lo, float hi) { unsigned r; asm volatile("v_cvt_pk_bf16_f32 %0, %1, %2" : "=v"(r) : "v"(lo), "v"(hi)); return r; }
typedef float f32x2 __attribute__((ext_vector_type(2)));

__device__ __forceinline__ float silu_f(float v) { return v * __builtin_amdgcn_rcpf(1.0f + __expf(-v)); }
__device__ __forceinline__ float sigm_f(float v) { return __builtin_amdgcn_rcpf(1.0f + __expf(-v)); }
__device__ __forceinline__ float bflo(unsigned w) { return __uint_as_float(w << 16); }
__device__ __forceinline__ float bfhi(unsigned w) { return __uint_as_float(w & 0xffff0000u); }

struct EpiProj {
    static constexpr bool PERM = true, AFTER_DRAIN = false;
    bf16_t* O; int ldc;
    __device__ __forceinline__ void operator()(const f32x4 (&acc)[2][2][4][2], const Unit& u, int wr, int wc, int fr, int fq) const {
        const int row0 = u.pm * BM + wr * 64 + fr, col0 = u.pn * BM + wc * 32 + 8 * fq;
        const int pn = u.pn; const bool gate = (pn == 6) | (pn == 7) | (pn == 14) | (pn == 15) | (pn == 18) | (pn == 19) | (pn == 22) | (pn == 23);
#pragma unroll
        for (int ai = 0; ai < 2; ++ai)
#pragma unroll
            for (int m = 0; m < 4; ++m) { bf16_t* rowp = O + (size_t)(row0 + ai * HALF + m * 16) * ldc + col0;
#pragma unroll
                for (int bj = 0; bj < 2; ++bj) { f32x4 v0 = acc[ai][bj][m][0], v1 = acc[ai][bj][m][1];
                    if (gate) {
#pragma unroll
                        for (int j = 0; j < 4; ++j) { v0[j] = silu_f(v0[j]); v1[j] = silu_f(v1[j]); } }
                    u32x4 w; w.x = cvt_pk_bf16(v0[0], v0[1]); w.y = cvt_pk_bf16(v0[2], v0[3]); w.z = cvt_pk_bf16(v1[0], v1[1]); w.w = cvt_pk_bf16(v1[2], v1[3]);
                    *(u32x4*)(rowp + bj * HALF) = w; } }
    }
};
struct EpiGlu {
    static constexpr bool PERM = true, AFTER_DRAIN = false;
    bf16_t* O; int ldo; const bf16_t* Y; int ldy; const bf16_t* G; int ldg; const float* bias;
    __device__ __forceinline__ void operator()(const f32x4 (&acc)[2][2][4][2], const Unit& u, int wr, int wc, int fr, int fq) const {
        const int row0 = u.pm * BM + wr * 64 + fr, col0 = u.pn * BM + wc * 32 + 8 * fq;
        f32x4 bv[2][2];
#pragma unroll
        for (int bj = 0; bj < 2; ++bj)
#pragma unroll
            for (int n = 0; n < 2; ++n) bv[bj][n] = *(const f32x4*)(bias + col0 + bj * HALF + 4 * n);
#pragma unroll
        for (int ai = 0; ai < 2; ++ai)
#pragma unroll
            for (int m = 0; m < 4; ++m) { const size_t row = (size_t)(row0 + ai * HALF + m * 16);
#pragma unroll
                for (int bj = 0; bj < 2; ++bj) { const int col = col0 + bj * HALF;
                    const u32x4 yv = *(const u32x4*)(Y + row * ldy + col), gv = *(const u32x4*)(G + row * ldg + col);
                    const f32x4 v0 = acc[ai][bj][m][0] + bv[bj][0], v1 = acc[ai][bj][m][1] + bv[bj][1];
                    u32x4 w;
                    w.x = cvt_pk_bf16(bflo(yv.x) * sigm_f(v0[0]) * bflo(gv.x), bfhi(yv.x) * sigm_f(v0[1]) * bfhi(gv.x));
                    w.y = cvt_pk_bf16(bflo(yv.y) * sigm_f(v0[2]) * bflo(gv.y), bfhi(yv.y) * sigm_f(v0[3]) * bfhi(gv.y));
                    w.z = cvt_pk_bf16(bflo(yv.z) * sigm_f(v1[0]) * bflo(gv.z), bfhi(yv.z) * sigm_f(v1[1]) * bfhi(gv.z));
                    w.w = cvt_pk_bf16(bflo(yv.w) * sigm_f(v1[2]) * bflo(gv.w), bfhi(yv.w) * sigm_f(v1[3]) * bfhi(gv.w));
                    *(u32x4*)(O + row * ldo + col) = w; } }
    }
};
struct EpiRes {
    static constexpr bool PERM = false, AFTER_DRAIN = false;
    const float* X; float* Z; int ldc; const float* gate; float alpha;
    __device__ __forceinline__ void operator()(const f32x4 (&acc)[2][2][4][2], const Unit& u, int wr, int wc, int fr, int fq) const {
        const int row0 = u.pm * BM + wr * 64 + fr, col0 = u.pn * BM + wc * 32 + 4 * fq;
        f32x4 gv[2][2];
#pragma unroll
        for (int bj = 0; bj < 2; ++bj)
#pragma unroll
            for (int n = 0; n < 2; ++n) gv[bj][n] = *(const f32x4*)(gate + col0 + bj * HALF + n * 16) + 1.0f;
#pragma unroll
        for (int ai = 0; ai < 2; ++ai)
#pragma unroll
            for (int m = 0; m < 4; ++m) { const size_t off = (size_t)(row0 + ai * HALF + m * 16) * ldc + col0;
#pragma unroll
                for (int bj = 0; bj < 2; ++bj)
#pragma unroll
                    for (int n = 0; n < 2; ++n) { const f32x4 xv = *(const f32x4*)(X + off + bj * HALF + n * 16);
                        *(f32x4*)(Z + off + bj * HALF + n * 16) = xv * alpha + gv[bj][n] * acc[ai][bj][m][n]; } }
    }
};

template <class Epi, class Sched, bool ALIGN_EPI = false, bool SP2 = false>
__device__ __forceinline__ void gemm_phase(PG8_LAS unsigned char* lds, const Gemm g, const Sched& S, const Epi& E) {
    int tid_ = threadIdx.x; asm volatile("" : "+v"(tid_));
    const int tid = tid_, wid = __builtin_amdgcn_readfirstlane(tid >> 6), lane = tid & 63, wr = wid >> 2, wc = wid & 3, fr = lane & 15, fq = lane >> 4;
    const int K = g.K, nt = K / BK;
    unsigned voffA[2], voffB[2];
#pragma unroll
    for (int i = 0; i < 2; ++i) { int R, C; stage_rc(tid * 16 + i * 8192, R, C); const int Rb = Epi::PERM ? ((R & ~31) + perm32(R & 31)) : R;
        voffA[i] = (unsigned)(R * K + C) * 2u; voffB[i] = (unsigned)(Rb * K + C) * 2u; }
    const size_t kstep = (size_t)(BK * 2);
    const size_t hstep = (size_t)HALF * K * 2;
    const size_t tstep = 2 * hstep;
    const unsigned ldsw = (unsigned)wid * 1024u;
    const int aoff = lds_byte(wr * 64 + fr, fq * 8), boff = lds_byte(wc * 32 + fr, fq * 8);
#define PG8_SA(b, h) (((b) * 2 + (h)) * HTB)
#define PG8_SB(b, h) ((4 + (b) * 2 + (h)) * HTB)
#define PG8_STAGE(bufoff, gbase, voff) do { _Pragma("unroll") for (int _i = 0; _i < 2; ++_i) \
        __builtin_amdgcn_global_load_lds((const unsigned*)((const char*)(gbase) + (voff)[_i]), (PG8_LAS unsigned*)(lds + (bufoff) + ldsw + _i * 8192), 16, 0, 0); } while (0)
#define PG8_LDA(dst, b, h) do { _Pragma("unroll") for (int m = 0; m < 4; ++m) _Pragma("unroll") for (int k = 0; k < 2; ++k) dst[m][k] = *(const PG8_LAS bf16x8*)(lds + PG8_SA(b, h) + aoff + m * 2048 + k * 1024); } while (0)
#define PG8_LDB(dst, b, h) do { _Pragma("unroll") for (int n = 0; n < 2; ++n) _Pragma("unroll") for (int k = 0; k < 2; ++k) dst[n][k] = *(const PG8_LAS bf16x8*)(lds + PG8_SB(b, h) + boff + n * 2048 + k * 1024); } while (0)
#define PG8_MMA(ai, bj, At, Bt) do { __builtin_amdgcn_s_setprio(1); _Pragma("unroll") for (int m = 0; m < 4; ++m) _Pragma("unroll") for (int n = 0; n < 2; ++n) _Pragma("unroll") for (int k = 0; k < 2; ++k) \
        acc[ai][bj][m][n] = __builtin_amdgcn_mfma_f32_16x16x32_bf16(Bt[n][k], At[m][k], acc[ai][bj][m][n], 0, 0, 0); __builtin_amdgcn_s_setprio(0); } while (0)
#define PG8_WAIT_V(n) asm volatile("s_waitcnt vmcnt(" #n ")" ::: "memory")
#define PG8_WAIT_L(n) asm volatile("s_waitcnt lgkmcnt(" #n ")" ::: "memory")
#define PG8_BAR __builtin_amdgcn_s_barrier()
#define PG8_SCHED __builtin_amdgcn_sched_barrier(0)
    Unit cur, nxt; int ui = 0;
    if (!S.next(0, cur)) return;
    f32x4 acc[2][2][4][2];
#pragma unroll
    for (int a = 0; a < 2; ++a)
#pragma unroll
        for (int b = 0; b < 2; ++b)
#pragma unroll
            for (int m = 0; m < 4; ++m)
#pragma unroll
                for (int n = 0; n < 2; ++n) acc[a][b][m][n] = (f32x4){0.f, 0.f, 0.f, 0.f};
    bf16x8 At[4][2], B0[2][2], B1[2][2];
    const char* cA = (const char*)g.A + (size_t)cur.pm * tstep; const char* cB = (const char*)g.Bt + (size_t)cur.pn * tstep;
    S.a_ready(cur);
    if constexpr (SP2) {
        PG8_STAGE(PG8_SB(0, 0), cB, voffB); PG8_STAGE(PG8_SB(0, 1), cB + hstep, voffB); PG8_STAGE(PG8_SA(0, 0), cA, voffA); PG8_STAGE(PG8_SA(0, 1), cA + hstep, voffA);
        if (wr == 1) PG8_BAR;
        PG8_WAIT_V(2); PG8_BAR;
        PG8_STAGE(PG8_SB(1, 0), cB + kstep, voffB); PG8_STAGE(PG8_SA(1, 0), cA + kstep, voffA); PG8_STAGE(PG8_SB(1, 1), cB + hstep + kstep, voffB);
        PG8_WAIT_V(6); PG8_BAR;
    } else {
        PG8_STAGE(PG8_SB(0, 0), cB, voffB); PG8_STAGE(PG8_SA(0, 0), cA, voffA); PG8_STAGE(PG8_SB(0, 1), cB + hstep, voffB); PG8_STAGE(PG8_SA(0, 1), cA + hstep, voffA);
        if (wr == 1) PG8_BAR;
        PG8_WAIT_V(4); PG8_BAR;
        PG8_STAGE(PG8_SB(1, 0), cB + kstep, voffB); PG8_STAGE(PG8_SA(1, 0), cA + kstep, voffA); PG8_STAGE(PG8_SB(1, 1), cB + hstep + kstep, voffB);
        PG8_WAIT_V(6); PG8_BAR;
    }
    for (;;) {
        const bool has_next = S.next(ui + 1, nxt);
        const char* nA = has_next ? (const char*)g.A + (size_t)nxt.pm * tstep : cA; const char* nB = has_next ? (const char*)g.Bt + (size_t)nxt.pn * tstep : cB;
        for (int t = 0; t < nt; t += 2) {
            const bool last = (t == nt - 2);
            const char* a1 = cA + (size_t)(t + 1) * kstep;
            const char* a2 = last ? nA : cA + (size_t)(t + 2) * kstep; const char* b2 = last ? nB : cB + (size_t)(t + 2) * kstep;
            const char* a3 = a2 + kstep; const char* b3 = b2 + kstep;
            if (last && has_next) S.a_ready(nxt);
            if constexpr (SP2) {
            PG8_LDB(B0, 0, 0); PG8_LDB(B1, 0, 1); PG8_SCHED; PG8_LDA(At, 0, 0); PG8_STAGE(PG8_SA(1, 1), a1 + hstep, voffA);
            PG8_WAIT_V(8); PG8_WAIT_L(0); PG8_BAR; PG8_MMA(0, 0, At, B0); PG8_MMA(0, 1, At, B1); PG8_BAR; PG8_SCHED;
            PG8_LDA(At, 0, 1); PG8_STAGE(PG8_SB(0, 0), b2, voffB); PG8_STAGE(PG8_SB(0, 1), b2 + hstep, voffB); PG8_STAGE(PG8_SA(0, 0), a2, voffA);
            PG8_WAIT_V(8); PG8_WAIT_L(0); PG8_BAR; PG8_MMA(1, 0, At, B0); PG8_MMA(1, 1, At, B1); PG8_BAR; PG8_SCHED;
            PG8_LDB(B0, 1, 0); PG8_LDB(B1, 1, 1); PG8_SCHED; PG8_LDA(At, 1, 0); PG8_STAGE(PG8_SA(0, 1), a2 + hstep, voffA);
            PG8_WAIT_V(8); PG8_WAIT_L(0); PG8_BAR; PG8_MMA(0, 0, At, B0); PG8_MMA(0, 1, At, B1); PG8_BAR; PG8_SCHED;
            PG8_LDA(At, 1, 1); PG8_STAGE(PG8_SB(1, 0), b3, voffB); PG8_STAGE(PG8_SB(1, 1), b3 + hstep, voffB); PG8_STAGE(PG8_SA(1, 0), a3, voffA);
            PG8_WAIT_V(8); PG8_WAIT_L(0); PG8_BAR; PG8_MMA(1, 0, At, B0); PG8_MMA(1, 1, At, B1); PG8_BAR; PG8_SCHED;
            } else {
            PG8_LDB(B0, 0, 0); PG8_SCHED; PG8_LDA(At, 0, 0); PG8_STAGE(PG8_SA(1, 1), a1 + hstep, voffA);
            PG8_WAIT_L(8); PG8_BAR; PG8_WAIT_L(0); PG8_MMA(0, 0, At, B0); PG8_BAR; PG8_SCHED;
            PG8_LDB(B1, 0, 1); PG8_STAGE(PG8_SB(0, 0), b2, voffB);
            PG8_BAR; PG8_WAIT_L(0); PG8_MMA(0, 1, At, B1); PG8_BAR;
            PG8_LDA(At, 0, 1); PG8_STAGE(PG8_SA(0, 0), a2, voffA);
            PG8_BAR; PG8_WAIT_L(0); PG8_MMA(1, 0, At, B0); PG8_BAR; PG8_SCHED;
            PG8_STAGE(PG8_SB(0, 1), b2 + hstep, voffB);
            PG8_WAIT_V(6); PG8_BAR; PG8_MMA(1, 1, At, B1); PG8_BAR;
            PG8_LDB(B0, 1, 0); PG8_SCHED; PG8_LDA(At, 1, 0); PG8_STAGE(PG8_SA(0, 1), a2 + hstep, voffA);
            PG8_WAIT_L(8); PG8_BAR; PG8_WAIT_L(0); PG8_MMA(0, 0, At, B0); PG8_BAR; PG8_SCHED;
            PG8_LDB(B1, 1, 1); PG8_STAGE(PG8_SB(1, 0), b3, voffB);
            PG8_BAR; PG8_WAIT_L(0); PG8_MMA(0, 1, At, B1); PG8_BAR;
            PG8_LDA(At, 1, 1); PG8_STAGE(PG8_SA(1, 0), a3, voffA);
            PG8_BAR; PG8_WAIT_L(0); PG8_MMA(1, 0, At, B0); PG8_BAR; PG8_SCHED;
            PG8_STAGE(PG8_SB(1, 1), b3 + hstep, voffB);
            PG8_WAIT_V(6); PG8_BAR; PG8_MMA(1, 1, At, B1); PG8_BAR;
            }
        }
        if constexpr (ALIGN_EPI) { if (wr == 0) PG8_BAR; }
        if constexpr (!Epi::AFTER_DRAIN) { E(acc, cur, wr, wc, fr, fq); S.done(cur); }
        if (!has_next) break;
#pragma unroll
        for (int a = 0; a < 2; ++a)
#pragma unroll
            for (int b = 0; b < 2; ++b)
#pragma unroll
                for (int m = 0; m < 4; ++m)
#pragma unroll
                    for (int n = 0; n < 2; ++n) acc[a][b][m][n] = (f32x4){0.f, 0.f, 0.f, 0.f};
        cur = nxt; cA = nA; cB = nB; ++ui;
        if constexpr (ALIGN_EPI) { if (wr == 1) PG8_BAR; }
    }
    PG8_WAIT_V(0);
    if constexpr (!ALIGN_EPI) { if (wr == 0) PG8_BAR; }
    PG8_BAR;
    if constexpr (Epi::AFTER_DRAIN) { E.fused(acc, cur, wr, wc, fr, fq, lds, wid, lane); S.done(cur); }
#undef PG8_SA
#undef PG8_SB
#undef PG8_STAGE
#undef PG8_LDA
#undef PG8_LDB
#undef PG8_MMA
#undef PG8_WAIT_V
#undef PG8_WAIT_L
#undef PG8_BAR
#undef PG8_SCHED
}
}

#ifndef MK_FUSED
#define MK_FUSED 1
#endif
#define GAS __attribute__((address_space(1)))
#define LAS __attribute__((address_space(3)))
typedef unsigned short bf16;
typedef unsigned v4u __attribute__((ext_vector_type(4)));
typedef unsigned v2u __attribute__((ext_vector_type(2)));
typedef float f32x4 __attribute__((ext_vector_type(4)));
typedef float f32x2 __attribute__((ext_vector_type(2)));
typedef float f32x16 __attribute__((ext_vector_type(16)));
typedef short bf16x8 __attribute__((ext_vector_type(8)));
typedef short s16x4 __attribute__((ext_vector_type(4)));
typedef GAS unsigned gu32;

constexpr int NWAVES = 8, NTHR = 512;
constexpr int SEQ = 8192, DM = 2048, NIN = 6144, BR = 512, DEPTH = 2;
constexpr int COL_AB = 0, COL_AC = 512, COL_AX = 1024, COL_AG = 1536, COL_Q = 2048, COL_K = 2560, COL_V = 3072, COL_BG = 3584, COL_CX = 4096, COL_CG = 4608, COL_DU = 5120, COL_DG = 5632;
constexpr float LN_EPS = 1e-5f;
constexpr float ALPHA = 1.41421356237309515f;
constexpr int LRU_LC = 256, LRU_NC = SEQ / LRU_LC;
constexpr int S5_LC = 128, S5_NC = SEQ / S5_LC;
constexpr int ADA_KC = 32;
constexpr size_t MiB = 1u << 20;
constexpr size_t WS_CTL = 0, CTL_ZERO_BYTES = 65536;
constexpr size_t WS_WIN = 2 * MiB;
constexpr size_t WS_WOUT = 50 * MiB;
constexpr size_t WS_WGLU = 66 * MiB;
constexpr size_t WS_LRUW = 67 * MiB;
constexpr size_t WS_S5P = 68 * MiB;
constexpr size_t S5P_LAM1 = 0, S5P_LAML = 16384, S5P_BBT = 65536, S5P_CMT = 262144, S5P_SP8 = 524288, S5P_STRIDE = MiB;
constexpr size_t WS_ADAP = 70 * MiB;
constexpr size_t WS_ADAF = 72 * MiB;
constexpr size_t WS_H = 74 * MiB;
constexpr size_t WS_PROJ = 106 * MiB;
constexpr size_t WS_OG = 202 * MiB;
constexpr size_t WS_LSE = 226 * MiB;
constexpr size_t WS_YG = 227 * MiB;
constexpr size_t WS_LRUC = 235 * MiB;
constexpr size_t WS_S5C = 236 * MiB;
constexpr size_t WS_Z = 240 * MiB;
constexpr size_t WS_END = 304 * MiB;
constexpr int CW_BAR = 1024;
constexpr int RING_BYTES = 131072, LDSCTL_OFF = RING_BYTES, MISC_OFF = LDSCTL_OFF + 320, LDS_BYTES = 147456;

#define RLX_AGENT __ATOMIC_RELAXED, __HIP_MEMORY_SCOPE_AGENT
#define LDS_WAIT() asm volatile("s_waitcnt lgkmcnt(0)" ::: "memory")
__device__ __forceinline__ unsigned f2bf(float f) { unsigned u = __builtin_bit_cast(unsigned, f); return (u + 0x7fffu + ((u >> 16) & 1u)) >> 16; }
__device__ __forceinline__ unsigned pk2(float lo, float hi) { return f2bf(lo) | (f2bf(hi) << 16); }
__device__ __forceinline__ float bf2f(unsigned short b) { return __uint_as_float(((unsigned)b) << 16); }
__device__ __forceinline__ float bflo(unsigned w) { return __uint_as_float(w << 16); }
__device__ __forceinline__ float bfhi(unsigned w) { return __uint_as_float(w & 0xffff0000u); }
__device__ __forceinline__ float sigm(float v) { return __builtin_amdgcn_rcpf(1.0f + __expf(-v)); }

#define XB_TMO      128
#define XB_XCNT(j)  (256  + 64 * (j))
#define XB_XSUB(j)  (1280 + 64 * (j))
#define XB_XGEN(j)  (2304 + 64 * (j))
#define XB_TOP      3328
#define XB_TOPGEN   3392
#define XCD_BAR_WORDS 3456
#define XB_SPIN_CAP (1u << 22)
__device__ __forceinline__ unsigned xb_ld(unsigned* p)              { return __hip_atomic_load(p, __ATOMIC_RELAXED, __HIP_MEMORY_SCOPE_AGENT); }
__device__ __forceinline__ unsigned xb_add(unsigned* p, unsigned v) { return __hip_atomic_fetch_add(p, v, __ATOMIC_RELAXED, __HIP_MEMORY_SCOPE_AGENT); }
__device__ __forceinline__ unsigned xb_xcc_id() { return (unsigned)__builtin_amdgcn_s_getreg((3 << 11) | 20) & 0xFu; }
#define XB_SPIN(cond, bar) do { unsigned _sp = 0; while (cond) { __builtin_amdgcn_s_sleep(1); \
    if ((++_sp & 255u) == 0u) { if (xb_ld(&(bar)[XB_TMO])) break; if (_sp > XB_SPIN_CAP) { atomicAdd(&(bar)[XB_TMO], 1u); break; } } } } while (0)
struct XcdBarrier { unsigned* bar; unsigned x; volatile LAS unsigned* st; };
__device__ __forceinline__ XcdBarrier xcd_barrier_post(unsigned* bar, volatile LAS unsigned* st) {
    XcdBarrier b; b.bar = bar; b.x = xb_xcc_id(); b.st = st;
    if (threadIdx.x == 0) (void)xb_add(&bar[XB_XCNT(b.x)], 1u);
    return b;
}
__device__ __forceinline__ void xcd_barrier_complete(unsigned* bar, unsigned x, unsigned& nloc, unsigned& nx) {
    const unsigned G = gridDim.x * gridDim.y * gridDim.z;
    unsigned sum, cnt, mine, sp = 0u;
    for (;;) {
        sum = 0u; cnt = 0u; mine = 0u;
#pragma unroll
        for (unsigned j = 0; j < 16; ++j) { const unsigned c = xb_ld(&bar[XB_XCNT(j)]); sum += c; cnt += (c > 0u) ? 1u : 0u; mine = (j == x) ? c : mine; }
        if (sum == G) break;
        __builtin_amdgcn_s_sleep(1);
        if ((++sp & 255u) == 0u) { if (xb_ld(&bar[XB_TMO])) break; if (sp > XB_SPIN_CAP) { atomicAdd(&bar[XB_TMO], 1u); break; } }
    }
    nloc = mine > 0u ? mine : 1u; nx = cnt > 0u ? cnt : 1u;
}
__device__ __forceinline__ void xcd_barrier(const XcdBarrier& b) {
    asm volatile("s_waitcnt vmcnt(0)" ::: "memory");
    __syncthreads();
    if (threadIdx.x == 0) {
        unsigned* bar = b.bar;
        __builtin_amdgcn_s_waitcnt(0);
        unsigned nloc = b.st[0], nx = b.st[1];
        if (nloc == 0u) { xcd_barrier_complete(bar, b.x, nloc, nx); b.st[0] = nloc; b.st[1] = nx; }
        const unsigned old = xb_add(&bar[XB_XSUB(b.x)], 1u);
        const unsigned gen = old / nloc;
        if (old + 1u == (gen + 1u) * nloc) {
            __builtin_amdgcn_fence(__ATOMIC_RELEASE, "agent");
            asm volatile("s_waitcnt vmcnt(0)" ::: "memory");
            const unsigned og = xb_add(&bar[XB_TOP], 1u);
            const unsigned tg = og / nx;
            if (og + 1u == (tg + 1u) * nx) xb_add(&bar[XB_TOPGEN], 1u);
            else XB_SPIN(xb_ld(&bar[XB_TOPGEN]) == tg, bar);
            __builtin_amdgcn_fence(__ATOMIC_ACQUIRE, "agent");
            xb_add(&bar[XB_XGEN(b.x)], 1u);
            asm volatile("s_waitcnt vmcnt(0)" ::: "memory");
        } else {
            XB_SPIN(xb_ld(&bar[XB_XGEN(b.x)]) == gen, bar);
            __builtin_amdgcn_fence(__ATOMIC_ACQUIRE, "agent");
            asm volatile("s_waitcnt vmcnt(0)" ::: "memory");
        }
    }
    __syncthreads();
}

struct Params { const float* in[27]; float* out; unsigned char* ws; int ph_lo, ph_hi; };
enum { I_X = 0, I_C, I_RELB, I_WADA, I_BADA, I_WIN, I_CONVA, I_CONVC, I_CONVCB, I_LRUWA, I_LRUBA, I_LRUWX, I_LRUBX, I_LRULAM, I_S5LRE, I_S5LIM, I_S5LDT, I_S5BRE, I_S5BIM,
       I_S5CRE, I_S5CIM, I_S5D, I_S5WGLU, I_S5BGLU, I_WOUT, I_LNG, I_LNB };

__device__ __forceinline__ void p0_ada_item(const float* c, const float* w_ada, float* adaP, int item, int lane) {
    const int kc = item & (ADA_KC - 1), rest = item >> 5, cb = rest % 24, l = rest / 24;
    const float* W = w_ada + (size_t)l * DM * NIN + (size_t)(kc * 64) * NIN + cb * 256 + lane * 4;
    f32x4 acc = (f32x4){0.f, 0.f, 0.f, 0.f};
#pragma unroll 8
    for (int k = 0; k < 64; ++k) { const float cv = c[kc * 64 + k]; const float s = cv / (1.0f + expf(-cv)); const f32x4 w = *(const f32x4*)(W + (size_t)k * NIN); acc += w * s; }
    *(f32x4*)(adaP + ((size_t)(kc * 2 + l)) * NIN + cb * 256 + lane * 4) = acc;
}
__device__ __forceinline__ void p0_transpose_item(const float* W, int K, int N, bf16* WT, int row_off, LAS float* scr, int item, int lane) {
    const int nblk = N / 32, kb = item / nblk, nb = item % nblk, k0 = 64 * kb, n0 = 32 * nb;
#pragma unroll 8
    for (int i = 0; i < 32; ++i) { const int kk = 2 * i + (lane >> 5); scr[kk * 33 + (lane & 31)] = W[(size_t)(k0 + kk) * N + n0 + (lane & 31)]; }
    LDS_WAIT(); asm volatile("" ::: "memory");
    const int c = lane & 7;
#pragma unroll
    for (int j = 0; j < 4; ++j) { const int n = (lane >> 3) + 8 * j; const LAS float* s = scr + (8 * c) * 33 + n;
        v4u o; o.x = pk2(s[0 * 33], s[1 * 33]); o.y = pk2(s[2 * 33], s[3 * 33]); o.z = pk2(s[4 * 33], s[5 * 33]); o.w = pk2(s[6 * 33], s[7 * 33]);
        *(GAS v4u*)(WT + (size_t)(row_off + n0 + n) * K + k0 + 8 * c) = o; }
    LDS_WAIT(); asm volatile("" ::: "memory");
}
__device__ __forceinline__ void p0_s5_param(const Params& p, int idx) {
    const int l = idx >> 11, g = (idx >> 6) & 31, pp = idx & 63, lg = l * 32 + g;
    unsigned char* base = p.ws + WS_S5P + (size_t)l * S5P_STRIDE;
    const double dt = exp((double)p.in[I_S5LDT][lg]);
    const double lr = (double)p.in[I_S5LRE][lg * 64 + pp], li = (double)p.in[I_S5LIM][lg * 64 + pp];
    const double mag = exp(lr * dt), th = li * dt; const double ar = mag * cos(th), ai = mag * sin(th);
    const double den = lr * lr + li * li; const double fr = ((ar - 1.0) * lr + ai * li) / den, fi = (ai * lr - (ar - 1.0) * li) / den;
    ((f32x2*)(base + S5P_LAM1))[g * 64 + pp] = (f32x2){(float)ar, (float)ai};
    const double magL = exp(lr * dt * (double)S5_LC), thL = th * (double)S5_LC;
    ((f32x2*)(base + S5P_LAML))[g * 64 + pp] = (f32x2){(float)(magL * cos(thL)), (float)(magL * sin(thL))};
    bf16* bbT = (bf16*)(base + S5P_BBT) + (size_t)g * 128 * 16; bf16* cmT = (bf16*)(base + S5P_CMT) + (size_t)g * 16 * 128;
    const float* bre = p.in[I_S5BRE] + ((size_t)lg * 64 + pp) * 16; const float* bim = p.in[I_S5BIM] + ((size_t)lg * 64 + pp) * 16;
    for (int c = 0; c < 16; ++c) { const double br = bre[c], bi = bim[c];
        bbT[pp * 16 + c] = (bf16)f2bf((float)(fr * br - fi * bi)); bbT[(64 + pp) * 16 + c] = (bf16)f2bf((float)(fr * bi + fi * br)); }
    const float* cre = p.in[I_S5CRE] + (size_t)lg * 16 * 64; const float* cim = p.in[I_S5CIM] + (size_t)lg * 16 * 64;
    for (int c = 0; c < 16; ++c) { cmT[c * 128 + 2 * pp] = (bf16)f2bf(cre[c * 64 + pp]); cmT[c * 128 + 2 * pp + 1] = (bf16)f2bf(-cim[c * 64 + pp]); }
}
__device__ __forceinline__ void phase_p0(const Params& p, LAS unsigned char* lds, int gw, int NGW, int wave, int lane) {
    float* adaP = (float*)(p.ws + WS_ADAP);
    for (int it = gw; it < 2 * 24 * ADA_KC; it += NGW) p0_ada_item(p.in[I_C], p.in[I_WADA], adaP, it, lane);
    LAS float* scr = (LAS float*)(lds + wave * 16384);
    constexpr int I_IN = (DM / 64) * (NIN / 32), I_OUT = (DM / 64) * (DM / 32), I_GLU = (BR / 64) * (BR / 32), I_LRU = 2;
    constexpr int NITEMS = 2 * I_IN + 2 * I_OUT + 2 * I_GLU + 2 * 8 * 2 * I_LRU;
    for (int it = gw; it < NITEMS; it += NGW) {
        int r = it;
        if (r < 2 * I_IN) { const int l = r / I_IN; p0_transpose_item(p.in[I_WIN] + (size_t)l * DM * NIN, DM, NIN, (bf16*)(p.ws + WS_WIN) + (size_t)l * NIN * DM, 0, scr, r % I_IN, lane); continue; } r -= 2 * I_IN;
        if (r < 2 * I_OUT) { const int l = r / I_OUT; p0_transpose_item(p.in[I_WOUT] + (size_t)l * DM * DM, DM, DM, (bf16*)(p.ws + WS_WOUT) + (size_t)l * DM * DM, 0, scr, r % I_OUT, lane); continue; } r -= 2 * I_OUT;
        if (r < 2 * I_GLU) { const int l = r / I_GLU; p0_transpose_item(p.in[I_S5WGLU] + (size_t)l * BR * BR, BR, BR, (bf16*)(p.ws + WS_WGLU) + (size_t)l * BR * BR, 0, scr, r % I_GLU, lane); continue; } r -= 2 * I_GLU;
        { const int item = r & 1, mat = (r >> 1) & 1, lh = r >> 2;
          p0_transpose_item(p.in[mat ? I_LRUWX : I_LRUWA] + (size_t)lh * 64 * 64, 64, 64, (bf16*)(p.ws + WS_LRUW) + (size_t)lh * 128 * 64, mat * 64, scr, item, lane); }
    }
    const int gt = gw * 64 + lane, NGT = NGW * 64;
    for (int i = gt; i < 2 * 32 * 64; i += NGT) p0_s5_param(p, i);
    for (int i = gt; i < 2 * BR; i += NGT) { const int l = i / BR, ch = i % BR; const double lam = (double)p.in[I_LRULAM][i];
        ((float*)(p.ws + WS_S5P + (size_t)l * S5P_STRIDE + S5P_SP8))[ch] = (float)(8.0 * log1p(exp(-lam))); }
}

__device__ __forceinline__ void phase_p1(const Params& p, LAS unsigned char* lds, int bid, int G, int gw, int NGW, int tid, int lane) {
    const float* adaP = (const float*)(p.ws + WS_ADAP); float* adaF = (float*)(p.ws + WS_ADAF);
    LAS float* sv = (LAS float*)lds;
    for (int n = tid; n < 2 * DM; n += NTHR) { float s = p.in[I_BADA][n];
        for (int kc = 0; kc < ADA_KC; ++kc) s += adaP[(size_t)(kc * 2 + 0) * NIN + n];
        sv[n] = (n >= DM) ? 1.0f + s : s; }
    for (int i = bid * NTHR + tid; i < 2 * NIN; i += G * NTHR) { const int l = i / NIN, n = i % NIN; float s = p.in[I_BADA][i];
        for (int kc = 0; kc < ADA_KC; ++kc) s += adaP[(size_t)(kc * 2 + l) * NIN + n];
        adaF[i] = s; }
    __syncthreads();
    const float* x = p.in[I_X]; bf16* h = (bf16*)(p.ws + WS_H);
    for (int row = gw; row < SEQ; row += NGW) {
        const float* xr = x + (size_t)row * DM; bf16* hr = h + (size_t)row * DM;
#pragma unroll
        for (int j = 0; j < 4; ++j) { const int col = j * 512 + lane * 8;
            const f32x4 a = *(const f32x4*)(xr + col), b = *(const f32x4*)(xr + col + 4);
            const f32x4 sa = *(const LAS f32x4*)(sv + col), sb = *(const LAS f32x4*)(sv + col + 4), ca = *(const LAS f32x4*)(sv + DM + col), cb = *(const LAS f32x4*)(sv + DM + col + 4);
            const f32x4 ha = a * ca + sa, hb = b * cb + sb;
            v4u o; o.x = pk2(ha[0], ha[1]); o.y = pk2(ha[2], ha[3]); o.z = pk2(hb[0], hb[1]); o.w = pk2(hb[2], hb[3]);
            *(v4u*)(hr + col) = o; }
    }
}

__device__ __forceinline__ s16x4 vtr(const LAS bf16* pz) { typedef short v4i16_t __attribute__((ext_vector_type(4))); return __builtin_bit_cast(s16x4, __builtin_amdgcn_ds_read_tr16_b64_v4i16((LAS v4i16_t*)pz)); }
__device__ __forceinline__ unsigned cvtpk(float lo, float hi) { typedef __bf16 bf16x2_t __attribute__((ext_vector_type(2))); f32x2 v = {lo, hi}; bf16x2_t b = __builtin_convertvector(v, bf16x2_t); return __builtin_bit_cast(unsigned, b); }
constexpr int ATT_LD = 72;
__device__ __forceinline__ void phase_attn(const Params& p, LAS unsigned char* lds, int bid, int G, int tid, int wave, int lane) {
    LAS bf16* Ks = (LAS bf16*)lds; LAS bf16* Vs = (LAS bf16*)(lds + 256 * ATT_LD * 2); LAS float* biasT = (LAS float*)(lds + 2 * 256 * ATT_LD * 2);
    for (int i = tid; i < 3 * 8 * 129; i += NTHR) { const int grp = i / (8 * 129), rem = i % (8 * 129), hh = rem / 129, d = rem % 129;
        const int dil = grp == 0 ? 1 : (grp == 1 ? 4 : 16); const int dist = d * dil; int bucket;
        if (dist < 16) bucket = dist; else { const float nf = (float)dist; const float v = logf(nf / 16.0f) / 4.852030263919617f * 16.0f; bucket = 16 + (int)v; bucket = bucket < 31 ? bucket : 31; }
        biasT[(grp * 8 + hh) * 132 + d] = p.in[I_RELB][bucket * 8 + hh]; }
    __syncthreads();
    const bf16* proj = (const bf16*)(p.ws + WS_PROJ); bf16* og = (bf16*)(p.ws + WS_OG); float* lse = (float*)(p.ws + WS_LSE);
    const int l15 = lane & 15, g4 = lane >> 4;
    v4u kreg[4], vreg[4]; bf16x8 qreg[2];
#define ATT_DECODE(it_) const int grp = (it_) >> 9, rem = (it_) & 511, hh = rem & 7, idx = rem >> 3; const int dil = grp == 0 ? 1 : (grp == 1 ? 4 : 16), nbk = 64 / dil, r = idx / nbk, n = idx % nbk;
#define ATT_LOAD(it_) do { ATT_DECODE(it_) \
        _Pragma("unroll") for (int i = 0; i < 4; ++i) { const int cid = tid + NTHR * i, row = cid >> 3, ch = cid & 7; const int sub = (n - 1) * 128 + row; const bool ok = sub >= 0; \
            const size_t tok = (size_t)(ok ? sub : 0) * dil + r; const v4u kv = *(const v4u*)(proj + tok * NIN + COL_K + hh * 64 + ch * 8), vv = *(const v4u*)(proj + tok * NIN + COL_V + hh * 64 + ch * 8); \
            kreg[i] = ok ? kv : (v4u){0u, 0u, 0u, 0u}; vreg[i] = ok ? vv : (v4u){0u, 0u, 0u, 0u}; } \
        const size_t tq_ = (size_t)(n * 128 + 16 * wave + l15) * dil + r; \
        _Pragma("unroll") for (int s = 0; s < 2; ++s) qreg[s] = *(const bf16x8*)(proj + tq_ * NIN + COL_Q + hh * 64 + 32 * s + 8 * g4); } while (0)
    if (bid < 1536) ATT_LOAD(bid);
    for (int it = bid; it < 1536; it += G) {
        ATT_DECODE(it)
#pragma unroll
        for (int i = 0; i < 4; ++i) { const int cid = tid + NTHR * i, row = cid >> 3, ch = cid & 7; *(LAS v4u*)(Ks + row * ATT_LD + ch * 8) = kreg[i]; *(LAS v4u*)(Vs + row * ATT_LD + ch * 8) = vreg[i]; }
        bf16x8 qf[2]; qf[0] = qreg[0]; qf[1] = qreg[1];
        __syncthreads();
        if (it + G < 1536) ATT_LOAD(it + G);
        const int iq = 16 * wave + l15; const size_t tokq = (size_t)(n * 128 + iq) * dil + r;
        f32x4 sc[10];
#pragma unroll
        for (int t = 0; t < 10; ++t) { int kt = wave + t; kt = kt < 15 ? kt : 15;
            const bf16x8 a0 = *(const LAS bf16x8*)(Ks + (kt * 16 + l15) * ATT_LD + 8 * g4), a1 = *(const LAS bf16x8*)(Ks + (kt * 16 + l15) * ATT_LD + 32 + 8 * g4);
            f32x4 acc = (f32x4){0.f, 0.f, 0.f, 0.f};
            acc = __builtin_amdgcn_mfma_f32_16x16x32_bf16(a0, qf[0], acc, 0, 0, 0);
            acc = __builtin_amdgcn_mfma_f32_16x16x32_bf16(a1, qf[1], acc, 0, 0, 0);
            sc[t] = acc; }
        const LAS float* bt = biasT + (grp * 8 + hh) * 132;
        float mx = -3.0e38f;
#pragma unroll
        for (int t = 0; t < 10; ++t)
#pragma unroll
            for (int q = 0; q < 4; ++q) { const int delta = l15 + 128 - 16 * t - 4 * g4 - q; const int j = 16 * (wave + t) + 4 * g4 + q;
                const bool valid = (delta >= 0) & (delta <= 128) & ((n > 0) | (j >= 128));
                const int dc = delta < 0 ? 0 : (delta > 128 ? 128 : delta);
                const float v = valid ? sc[t][q] * 0.125f + bt[dc] : -1.0e30f; sc[t][q] = v; mx = fmaxf(mx, v); }
        mx = fmaxf(mx, __shfl_xor(mx, 16)); mx = fmaxf(mx, __shfl_xor(mx, 32));
        float ls = 0.f;
#pragma unroll
        for (int t = 0; t < 10; ++t)
#pragma unroll
            for (int q = 0; q < 4; ++q) { const float e = __expf(sc[t][q] - mx); sc[t][q] = e; ls += e; }
        ls += __shfl_xor(ls, 16); ls += __shfl_xor(ls, 32);
        f32x4 o[4];
#pragma unroll
        for (int d0 = 0; d0 < 4; ++d0) o[d0] = (f32x4){0.f, 0.f, 0.f, 0.f};
        const int vq = l15 >> 2, vp = lane & 3;
#pragma unroll
        for (int pp = 0; pp < 5; ++pp) { const int ta = 2 * pp, tb = 2 * pp + 1; int ka = wave + ta, kb = wave + tb; ka = ka < 15 ? ka : 15; kb = kb < 15 ? kb : 15;
            v4u pw; pw.x = cvtpk(sc[ta][0], sc[ta][1]); pw.y = cvtpk(sc[ta][2], sc[ta][3]); pw.z = cvtpk(sc[tb][0], sc[tb][1]); pw.w = cvtpk(sc[tb][2], sc[tb][3]);
            const bf16x8 pf = __builtin_bit_cast(bf16x8, pw);
#pragma unroll
            for (int d0 = 0; d0 < 4; ++d0) { const s16x4 lo = vtr(Vs + (ka * 16 + 4 * g4 + vq) * ATT_LD + d0 * 16 + 4 * vp), hi = vtr(Vs + (kb * 16 + 4 * g4 + vq) * ATT_LD + d0 * 16 + 4 * vp);
                const bf16x8 vf = (bf16x8){lo[0], lo[1], lo[2], lo[3], hi[0], hi[1], hi[2], hi[3]};
                o[d0] = __builtin_amdgcn_mfma_f32_16x16x32_bf16(vf, pf, o[d0], 0, 0, 0); } }
        const float inv = 1.0f / ls;
        bf16* orow = og + ((size_t)grp * SEQ + tokq) * BR + hh * 64 + 4 * g4;
#pragma unroll
        for (int d0 = 0; d0 < 4; ++d0) { v2u w; w.x = pk2(o[d0][0] * inv, o[d0][1] * inv); w.y = pk2(o[d0][2] * inv, o[d0][3] * inv); *(v2u*)(orow + d0 * 16) = w; }
        if (g4 == 0) lse[((size_t)grp * SEQ + tokq) * 8 + hh] = mx + logf(ls);
        __syncthreads();
    }
#undef ATT_LOAD
#undef ATT_DECODE
}

__device__ __forceinline__ void phase_mixa(const Params& p, int l, int bid, int G, int tid) {
    const bf16* proj = (const bf16*)(p.ws + WS_PROJ); bf16* cat = (bf16*)(p.ws + WS_H);
    const int co = (tid & 63) * 8, tq = tid >> 6;
    float w[3][8];
#pragma unroll
    for (int j = 0; j < 3; ++j)
#pragma unroll
        for (int e = 0; e < 8; ++e) w[j][e] = p.in[I_CONVA][((size_t)l * 3 + j) * BR + co + e];
    for (int it = bid; it < SEQ / 32; it += G) {
        const int tb = it * 32 + tq * 4;
        float pr[6][8];
#pragma unroll
        for (int k = 0; k < 6; ++k) { const int tok = tb - 2 + k;
            if (tok >= 0) { const v4u a = *(const v4u*)(proj + (size_t)tok * NIN + COL_AC + co), b = *(const v4u*)(proj + (size_t)tok * NIN + COL_AX + co);
                pr[k][0] = bflo(a.x) * bflo(b.x); pr[k][1] = bfhi(a.x) * bfhi(b.x); pr[k][2] = bflo(a.y) * bflo(b.y); pr[k][3] = bfhi(a.y) * bfhi(b.y);
                pr[k][4] = bflo(a.z) * bflo(b.z); pr[k][5] = bfhi(a.z) * bfhi(b.z); pr[k][6] = bflo(a.w) * bflo(b.w); pr[k][7] = bfhi(a.w) * bfhi(b.w); }
            else {
#pragma unroll
                for (int e = 0; e < 8; ++e) pr[k][e] = 0.f; } }
#pragma unroll
        for (int k = 0; k < 4; ++k) { const size_t tok = (size_t)(tb + k);
            const v4u ab = *(const v4u*)(proj + tok * NIN + COL_AB + co), ag = *(const v4u*)(proj + tok * NIN + COL_AG + co);
            float y[8];
#pragma unroll
            for (int e = 0; e < 8; ++e) y[e] = w[0][e] * pr[k][e] + w[1][e] * pr[k + 1][e] + w[2][e] * pr[k + 2][e];
            v4u o;
            o.x = pk2(y[0] * bflo(ab.x) * bflo(ag.x), y[1] * bfhi(ab.x) * bfhi(ag.x)); o.y = pk2(y[2] * bflo(ab.y) * bflo(ag.y), y[3] * bfhi(ab.y) * bfhi(ag.y));
            o.z = pk2(y[4] * bflo(ab.z) * bflo(ag.z), y[5] * bfhi(ab.z) * bfhi(ag.z)); o.w = pk2(y[6] * bflo(ab.w) * bflo(ag.w), y[7] * bfhi(ab.w) * bfhi(ag.w));
            *(v4u*)(cat + tok * DM + co) = o; }
    }
}
__device__ __forceinline__ void phase_attn_combine(const Params& p, int bid, int G, int tid) {
    const bf16* proj = (const bf16*)(p.ws + WS_PROJ); bf16* cat = (bf16*)(p.ws + WS_H); const bf16* og = (const bf16*)(p.ws + WS_OG); const float* lse = (const float*)(p.ws + WS_LSE);
    for (int it = bid; it < SEQ / 32; it += G) {
#pragma unroll
        for (int i = 0; i < 4; ++i) { const int pair = tid + NTHR * i; const size_t tok = (size_t)it * 32 + (pair >> 6); const int oc = pair & 63, hh = oc >> 3;
            const float l0 = lse[(0 * (size_t)SEQ + tok) * 8 + hh], l1 = lse[(1 * (size_t)SEQ + tok) * 8 + hh], l2 = lse[(2 * (size_t)SEQ + tok) * 8 + hh];
            const float m = fmaxf(l0, fmaxf(l1, l2)); float w0 = __expf(l0 - m), w1 = __expf(l1 - m), w2 = __expf(l2 - m); const float inv = 1.0f / (w0 + w1 + w2); w0 *= inv; w1 *= inv; w2 *= inv;
            const v4u a = *(const v4u*)(og + (0 * (size_t)SEQ + tok) * BR + oc * 8), b = *(const v4u*)(og + (1 * (size_t)SEQ + tok) * BR + oc * 8), c = *(const v4u*)(og + (2 * (size_t)SEQ + tok) * BR + oc * 8);
            const v4u gt = *(const v4u*)(proj + tok * NIN + COL_BG + oc * 8);
            v4u o;
            o.x = pk2((w0 * bflo(a.x) + w1 * bflo(b.x) + w2 * bflo(c.x)) * bflo(gt.x), (w0 * bfhi(a.x) + w1 * bfhi(b.x) + w2 * bfhi(c.x)) * bfhi(gt.x));
            o.y = pk2((w0 * bflo(a.y) + w1 * bflo(b.y) + w2 * bflo(c.y)) * bflo(gt.y), (w0 * bfhi(a.y) + w1 * bfhi(b.y) + w2 * bfhi(c.y)) * bfhi(gt.y));
            o.z = pk2((w0 * bflo(a.z) + w1 * bflo(b.z) + w2 * bflo(c.z)) * bflo(gt.z), (w0 * bfhi(a.z) + w1 * bfhi(b.z) + w2 * bfhi(c.z)) * bfhi(gt.z));
            o.w = pk2((w0 * bflo(a.w) + w1 * bflo(b.w) + w2 * bflo(c.w)) * bflo(gt.w), (w0 * bfhi(a.w) + w1 * bfhi(b.w) + w2 * bfhi(c.w)) * bfhi(gt.w));
            *(v4u*)(cat + tok * DM + BR + oc * 8) = o; }
    }
}

constexpr int LRU_XB_LD = 72;
constexpr int LRU_WAVE_LDS = 32 * 64 * 4 + 32 * LRU_XB_LD * 2;
constexpr int LRU_COMP_OFF = NWAVES * LRU_WAVE_LDS;
static_assert(LRU_NC == 32, "the carry composition assumes 32 chunks (8 parts x 4)");
__device__ __forceinline__ float lru_scan4(const float (&av)[16], float (&bv)[16], float h, int hf, bool keep) {
#pragma unroll
    for (int j = 0; j < 4; ++j) {
        float e0 = h;
#pragma unroll
        for (int q = 0; q < 4; ++q) e0 = av[4 * j + q] * e0 + bv[4 * j + q];
        const float e0o = __shfl_xor(e0, 32);
        float xs = hf ? e0o : h;
#pragma unroll
        for (int q = 0; q < 4; ++q) { xs = av[4 * j + q] * xs + bv[4 * j + q]; if (keep) bv[4 * j + q] = xs; }
        const float xo = __shfl_xor(xs, 32);
        h = hf ? xs : xo;
    }
    return h;
}
template <bool PASS2>
__device__ __forceinline__ void lru_block_item(const Params& p, int l, LAS unsigned char* lds, int c, int hd, int wave, int lane) {
    LAS unsigned char* wl = lds + wave * LRU_WAVE_LDS;
    LAS float* xcf = (LAS float*)wl; LAS bf16* xcb = (LAS bf16*)(wl + 32 * 64 * 4);
    LAS float* comp = (LAS float*)(lds + LRU_COMP_OFF); LAS float* hin = comp + NWAVES * 64 * 2;
    const bf16* proj = (const bf16*)(p.ws + WS_PROJ); bf16* cat = (bf16*)(p.ws + WS_H);
    float* lruA = (float*)(p.ws + WS_LRUC); float* lruH = lruA + LRU_NC * BR;
    const bf16* wT = (const bf16*)(p.ws + WS_LRUW) + (size_t)(l * 8 + hd) * 128 * 64;
    const float* sp8 = (const float*)(p.ws + WS_S5P + (size_t)l * S5P_STRIDE + S5P_SP8);
    const int s = lane & 31, hf = lane >> 5, chl = hd * 64 + lane;
    const int t0 = c * LRU_LC + 32 * wave;
    float cA = 1.f, cH = 0.f;
    if (PASS2) { const int ch = hd * 64 + wave * 8 + (lane & 7), part = lane >> 3;
        float a4[4], h4[4];
#pragma unroll
        for (int k = 0; k < 4; ++k) { const int cc = part * 4 + k; a4[k] = lruA[(size_t)cc * BR + ch]; h4[k] = lruH[(size_t)cc * BR + ch]; }
#pragma unroll
        for (int k = 0; k < 4; ++k) { const int cc = part * 4 + k; const float a = cc < c ? a4[k] : 1.f, h = cc < c ? h4[k] : 0.f; cH = a * cH + h; cA = a * cA; } }
    float xin[35];
#pragma unroll
    for (int t = 0; t < 35; ++t) { const int tok = t0 - 3 + t; xin[t] = tok >= 0 ? bf2f(proj[(size_t)(tok < 0 ? 0 : tok) * NIN + COL_CX + chl]) : 0.f; }
    float cw[4];
#pragma unroll
    for (int j = 0; j < 4; ++j) cw[j] = p.in[I_CONVC][((size_t)l * 4 + j) * BR + chl];
    const float cbias = p.in[I_CONVCB][(size_t)l * BR + chl];
#pragma unroll
    for (int t = 0; t < 32; ++t) { const float xc = cw[0] * xin[t] + cw[1] * xin[t + 1] + cw[2] * xin[t + 2] + cw[3] * xin[t + 3] + cbias;
        xcf[t * 64 + lane] = xc; xcb[t * LRU_XB_LD + lane] = (bf16)f2bf(xc); }
    LDS_WAIT(); asm volatile("" ::: "memory");
    bf16x8 af[4];
#pragma unroll
    for (int ks = 0; ks < 4; ++ks) af[ks] = *(const LAS bf16x8*)(xcb + s * LRU_XB_LD + ks * 16 + 8 * hf);
    float av[2][16], bv[2][16];
#pragma unroll
    for (int e = 0; e < 2; ++e) {
        const int ch = hd * 64 + s + 32 * e; const float ba = p.in[I_LRUBA][(size_t)l * BR + ch], bx = p.in[I_LRUBX][(size_t)l * BR + ch], sp = sp8[ch];
        f32x16 accr, acci;
#pragma unroll
        for (int q = 0; q < 16; ++q) { accr[q] = 0.f; acci[q] = 0.f; }
#pragma unroll
        for (int ks = 0; ks < 4; ++ks) { const bf16x8 br = *(const bf16x8*)(wT + (size_t)(32 * e + s) * 64 + ks * 16 + 8 * hf), bi = *(const bf16x8*)(wT + (size_t)(64 + 32 * e + s) * 64 + ks * 16 + 8 * hf);
            accr = __builtin_amdgcn_mfma_f32_32x32x16_bf16(af[ks], br, accr, 0, 0, 0); acci = __builtin_amdgcn_mfma_f32_32x32x16_bf16(af[ks], bi, acci, 0, 0, 0); }
#pragma unroll
        for (int q = 0; q < 16; ++q) { const int tt = (q & 3) + 8 * (q >> 2) + 4 * hf;
            const float rg = sigm(accr[q] + ba), ig = sigm(acci[q] + bx);
            const float la = -rg * sp; const float a = __expf(la); const float z = 2.0f * la;
            const float em = z * (1.0f + z * (1.0f / 2.0f) * (1.0f + z * (1.0f / 3.0f) * (1.0f + z * 0.25f * (1.0f + z * 0.2f * (1.0f + z * (1.0f / 6.0f) * (1.0f + z * (1.0f / 7.0f)))))));
            const float one_m = (z > -0.3f) ? -em : (1.0f - __expf(z));
            av[e][q] = a; bv[e][q] = sqrtf(one_m) * ig * xcf[tt * 64 + s + 32 * e]; }
        float pa = 1.f;
#pragma unroll
        for (int q = 0; q < 16; ++q) pa *= av[e][q];
        pa *= __shfl_xor(pa, 32);
        const float he = lru_scan4(av[e], bv[e], 0.f, hf, false);
        if (hf == 0) { comp[(wave * 64 + s + 32 * e) * 2] = pa; comp[(wave * 64 + s + 32 * e) * 2 + 1] = he; }
    }
    if (PASS2) {
        float H = 0.f;
#pragma unroll
        for (int pt = 0; pt < 8; ++pt) { const float a = __shfl(cA, (lane & 7) + 8 * pt), h = __shfl(cH, (lane & 7) + 8 * pt); H = a * H + h; }
        if (lane < 8) hin[wave * 8 + lane] = H;
    }
    LDS_WAIT(); __syncthreads();
    if (!PASS2) {
        if (wave == 0) { float A = 1.f, H = 0.f;
#pragma unroll
            for (int w = 0; w < NWAVES; ++w) { const float a = comp[(w * 64 + lane) * 2], h = comp[(w * 64 + lane) * 2 + 1]; H = a * H + h; A = a * A; }
            lruA[(size_t)c * BR + chl] = A; lruH[(size_t)c * BR + chl] = H; }
    } else {
#pragma unroll
        for (int e = 0; e < 2; ++e) { float H = hin[s + 32 * e];
            for (int w = 0; w < wave; ++w) { const float a = comp[(w * 64 + s + 32 * e) * 2], h = comp[(w * 64 + s + 32 * e) * 2 + 1]; H = a * H + h; }
            (void)lru_scan4(av[e], bv[e], H, hf, true);
#pragma unroll
            for (int q = 0; q < 16; ++q) { const int tt = (q & 3) + 8 * (q >> 2) + 4 * hf; xcf[tt * 64 + s + 32 * e] = bv[e][q]; } }
        LDS_WAIT(); asm volatile("" ::: "memory");
#pragma unroll
        for (int i = 0; i < 4; ++i) { const int tt = i * 8 + (lane >> 3), c8 = (lane & 7) * 8; const size_t tok = (size_t)(t0 + tt);
            const v4u gv = *(const v4u*)(proj + tok * NIN + COL_CG + hd * 64 + c8);
            const f32x4 h0 = *(const LAS f32x4*)(xcf + tt * 64 + c8), h1 = *(const LAS f32x4*)(xcf + tt * 64 + c8 + 4);
            v4u o; o.x = pk2(h0[0] * bflo(gv.x), h0[1] * bfhi(gv.x)); o.y = pk2(h0[2] * bflo(gv.y), h0[3] * bfhi(gv.y)); o.z = pk2(h1[0] * bflo(gv.z), h1[1] * bfhi(gv.z)); o.w = pk2(h1[2] * bflo(gv.w), h1[3] * bfhi(gv.w));
            *(v4u*)(cat + tok * DM + 2 * BR + hd * 64 + c8) = o; }
    }
    LDS_WAIT(); __syncthreads();
}

constexpr int S5_X_LD = 136;
constexpr int S5_WAVE_LDS = 32 * S5_X_LD * 2;
template <bool PASS2>
__device__ __forceinline__ void s5_item(const Params& p, int l, LAS unsigned char* wl, int c, int g, int lane) {
    LAS bf16* Xt = (LAS bf16*)wl;
    const bf16* proj = (const bf16*)(p.ws + WS_PROJ); bf16* yg = (bf16*)(p.ws + WS_YG); float* s5x = (float*)(p.ws + WS_S5C);
    const unsigned char* pb = p.ws + WS_S5P + (size_t)l * S5P_STRIDE;
    const f32x2* lam1 = (const f32x2*)(pb + S5P_LAM1) + g * 64; const f32x2* lamL = (const f32x2*)(pb + S5P_LAML) + g * 64;
    const bf16* bbT = (const bf16*)(pb + S5P_BBT) + (size_t)g * 128 * 16; const bf16* cmT = (const bf16*)(pb + S5P_CMT) + (size_t)g * 16 * 128;
    const int s = lane & 31, hf = lane >> 5, l15 = lane & 15, g4 = lane >> 4;
    bf16x8 bb[4];
#pragma unroll
    for (int nb = 0; nb < 4; ++nb) bb[nb] = *(const bf16x8*)(bbT + (size_t)(nb * 32 + s) * 16 + 8 * hf);
    float lr[2], li[2], xr[2], xi[2];
#pragma unroll
    for (int e = 0; e < 2; ++e) { const f32x2 v = lam1[s + 32 * e]; lr[e] = v.x; li[e] = v.y; xr[e] = 0.f; xi[e] = 0.f; }
    if (PASS2) {
        const f32x2 vA = lamL[s], vB = lamL[s + 32];
        for (int cb = 0; cb < c; cb += 16) {
            float ur[2][16], ui[2][16];
#pragma unroll
            for (int k = 0; k < 16; ++k) { int cc = cb + k; cc = cc < S5_NC ? cc : S5_NC - 1; const float* q = s5x + ((size_t)cc * 32 + g) * 128 + s;
                ur[0][k] = q[0]; ur[1][k] = q[32]; ui[0][k] = q[64]; ui[1][k] = q[96]; }
#pragma unroll
            for (int k = 0; k < 16; ++k) { const bool on = (cb + k) < c;
#pragma unroll
                for (int e = 0; e < 2; ++e) { const float ar = on ? (e ? vB.x : vA.x) : 1.f, ai = on ? (e ? vB.y : vA.y) : 0.f, vr = on ? ur[e][k] : 0.f, vi = on ? ui[e][k] : 0.f;
                    const float nr = ar * xr[e] - ai * xi[e] + vr, ni = ar * xi[e] + ai * xr[e] + vi; xr[e] = nr; xi[e] = ni; } }
        }
    }
    bf16x8 cm[4]; float dsk = 0.f;
    if (PASS2) {
#pragma unroll
        for (int ks = 0; ks < 4; ++ks) cm[ks] = *(const bf16x8*)(cmT + (size_t)l15 * 128 + ks * 32 + 8 * g4);
        dsk = p.in[I_S5D][(size_t)l * BR + g * 16 + l15];
    }
    for (int tile = 0; tile < S5_LC / 32; ++tile) {
        const int t0 = c * S5_LC + tile * 32;
        const bf16x8 uf = *(const bf16x8*)(proj + (size_t)(t0 + s) * NIN + COL_DU + g * 16 + 8 * hf);
        f32x16 zero16;
#pragma unroll
        for (int q = 0; q < 16; ++q) zero16[q] = 0.f;
#pragma unroll
        for (int e = 0; e < 2; ++e) {
            f32x16 br = __builtin_amdgcn_mfma_f32_32x32x16_bf16(uf, bb[e], zero16, 0, 0, 0);
            f32x16 bi = __builtin_amdgcn_mfma_f32_32x32x16_bf16(uf, bb[2 + e], zero16, 0, 0, 0);
            float hr = xr[e], hi = xi[e]; const float ar = lr[e], ai = li[e];
#pragma unroll
            for (int j = 0; j < 4; ++j) {
                float er = hr, ei = hi;
#pragma unroll
                for (int q = 0; q < 4; ++q) { const float nr = ar * er - ai * ei + br[4 * j + q], ni = ar * ei + ai * er + bi[4 * j + q]; er = nr; ei = ni; }
                const float ero = __shfl_xor(er, 32), eio = __shfl_xor(ei, 32);
                float sr = hf ? ero : hr, si = hf ? eio : hi;
#pragma unroll
                for (int q = 0; q < 4; ++q) { const float nr = ar * sr - ai * si + br[4 * j + q], ni = ar * si + ai * sr + bi[4 * j + q]; sr = nr; si = ni;
                    if (PASS2) { const int tt = q + 8 * j + 4 * hf; *(LAS unsigned*)(Xt + tt * S5_X_LD + 2 * (s + 32 * e)) = pk2(sr, si); } }
                const float sro = __shfl_xor(sr, 32), sio = __shfl_xor(si, 32);
                hr = hf ? sr : sro; hi = hf ? si : sio;
            }
            xr[e] = hr; xi[e] = hi;
        }
        if (PASS2) {
            LDS_WAIT(); asm volatile("" ::: "memory");
#pragma unroll
            for (int rt = 0; rt < 2; ++rt) {
                f32x4 acc = (f32x4){0.f, 0.f, 0.f, 0.f};
#pragma unroll
                for (int ks = 0; ks < 4; ++ks) { const bf16x8 a = *(const LAS bf16x8*)(Xt + (rt * 16 + l15) * S5_X_LD + ks * 32 + 8 * g4);
                    acc = __builtin_amdgcn_mfma_f32_16x16x32_bf16(a, cm[ks], acc, 0, 0, 0); }
#pragma unroll
                for (int q = 0; q < 4; ++q) { const size_t tok = (size_t)(t0 + rt * 16 + 4 * g4 + q); const float u = bf2f(proj[tok * NIN + COL_DU + g * 16 + l15]);
                    const float y = acc[q] + dsk * u; const float yy = y * sigm(1.5957691216057308f * (y + 0.044715f * y * y * y));
                    yg[tok * BR + g * 16 + l15] = (bf16)f2bf(yy); }
            }
            LDS_WAIT(); asm volatile("" ::: "memory");
        }
    }
    if (!PASS2 && hf == 0) {
#pragma unroll
        for (int e = 0; e < 2; ++e) { s5x[((size_t)c * 32 + g) * 128 + s + 32 * e] = xr[e]; s5x[((size_t)c * 32 + g) * 128 + 64 + s + 32 * e] = xi[e]; } }
}

__device__ __forceinline__ void phase_ln(const Params& p, int l, int gw, int NGW, int lane) {
    const float* z = (const float*)(p.ws + WS_Z); float* xo = p.out; bf16* h = (bf16*)(p.ws + WS_H); const float* lg = p.in[I_LNG] + (size_t)l * DM; const float* lb = p.in[I_LNB] + (size_t)l * DM;
    const float* adaF = (const float*)(p.ws + WS_ADAF) + (size_t)(l + 1 < DEPTH ? l + 1 : l) * NIN;
    for (int row = gw; row < SEQ; row += NGW) {
        const float* zr = z + (size_t)row * DM + 4 * lane; float* xr = xo + (size_t)row * DM + 4 * lane;
        f32x4 v[8]; float s = 0.f;
#pragma unroll
        for (int j = 0; j < 8; ++j) { v[j] = *(const f32x4*)(zr + 256 * j); s += (v[j][0] + v[j][1]) + (v[j][2] + v[j][3]); }
#pragma unroll
        for (int o = 1; o < 64; o <<= 1) s += __shfl_xor(s, o);
        const float mean = s * (1.0f / DM); float q = 0.f;
#pragma unroll
        for (int j = 0; j < 8; ++j) { v[j] = v[j] - mean; q += (v[j][0] * v[j][0] + v[j][1] * v[j][1]) + (v[j][2] * v[j][2] + v[j][3] * v[j][3]); }
#pragma unroll
        for (int o = 1; o < 64; o <<= 1) q += __shfl_xor(q, o);
        const float rstd = 1.0f / sqrtf(q * (1.0f / DM) + LN_EPS);
#pragma unroll
        for (int j = 0; j < 8; ++j) { const int col = 4 * lane + 256 * j; const f32x4 gg = *(const f32x4*)(lg + col), bb = *(const f32x4*)(lb + col);
            const f32x4 o = v[j] * rstd * gg + bb; *(f32x4*)(xr + 256 * j) = o;
            if (l + 1 < DEPTH) { const f32x4 sh = *(const f32x4*)(adaF + col), sc = *(const f32x4*)(adaF + DM + col); const f32x4 hv = o * (sc + 1.0f) + sh;
                v2u w; w.x = pk2(hv[0], hv[1]); w.y = pk2(hv[2], hv[3]); *(v2u*)(h + (size_t)row * DM + col) = w; } }
    }
}

constexpr int NPHASE = 2 + 6 * DEPTH;
__global__ void __launch_bounds__(NTHR, 2) mk_fwd(Params p_) {
    extern __shared__ __attribute__((aligned(16))) unsigned char lds_raw[];
    LAS unsigned char* lds = (LAS unsigned char*)lds_raw;
    const int G = gridDim.x, bid = blockIdx.x;
    const int vcu = (G % 8 == 0) ? (bid % 8) * (G / 8) + bid / 8 : bid;
    const int NGW = G * NWAVES;
    volatile LAS unsigned* MISC = (volatile LAS unsigned*)(lds + MISC_OFF);
    for (int u = threadIdx.x; u < (LDS_BYTES - LDSCTL_OFF) / 4; u += NTHR) ((LAS unsigned*)(lds + LDSCTL_OFF))[u] = 0u;
#define IDS() int tid = threadIdx.x; asm volatile("" : "+v"(tid)); const int lane = tid & 63, wave = __builtin_amdgcn_readfirstlane(tid >> 6), gw = vcu * NWAVES + wave; (void)lane; (void)gw; \
              Params p = p_; { unsigned long long z_ = 0; asm volatile("" : "+s"(z_)); p.ws = p_.ws + z_; }
    __syncthreads();
    XcdBarrier bar; bar.bar = (unsigned*)(p_.ws + WS_CTL) + CW_BAR; bar.x = 0; bar.st = nullptr;
    const int lo = p_.ph_lo, hi = p_.ph_hi;
    if (hi - lo > 1) bar = xcd_barrier_post((unsigned*)(p_.ws + WS_CTL) + CW_BAR, MISC + 8);
#ifndef PHMASK
#define PHMASK 0x1FFF
#endif
#define EN(t) (((PHMASK) >> (t)) & 1)
#ifndef REPMASK
#define REPMASK 0
#endif
#define REP(t) for (int rep_ = 0; rep_ < 1 + (((REPMASK) >> (t)) & 1); ++rep_)
#define IN(k) (lo <= (k) && (k) < hi)
#ifndef SEAMREP
#define SEAMREP 1
#endif
#define SEAM(k) do { if (IN(k) && IN((k) + 1)) for (int sr_ = 0; sr_ < SEAMREP; ++sr_) xcd_barrier(bar); } while (0)
    if (EN(0) && IN(0)) REP(0) { IDS(); phase_p0(p, lds, gw, NGW, wave, lane); } SEAM(0);
    if (EN(1) && IN(1)) REP(1) { IDS(); phase_p1(p, lds, vcu, G, gw, NGW, tid, lane); } SEAM(1);
#pragma unroll
    for (int l = 0; l < DEPTH; ++l) {
        const int pb = 2 + 6 * l;
        if (EN(2) && IN(pb + 0)) REP(2) { IDS();
            pg8::Gemm g{(const pg8::bf16_t*)(p.ws + WS_H), (const pg8::bf16_t*)(p.ws + WS_WIN) + (size_t)l * NIN * DM, SEQ, NIN, DM}; pg8::StaticOrder S; S.init(SEQ, NIN, G, bid);
            pg8::EpiProj E{(pg8::bf16_t*)(p.ws + WS_PROJ), NIN};
            pg8::gemm_phase<pg8::EpiProj, pg8::StaticOrder, true, true>(lds, g, S, E);
        } SEAM(pb + 0);
        if (IN(pb + 1)) { IDS();
            if (EN(3)) REP(3) phase_attn(p, lds, vcu, G, tid, wave, lane);
            __syncthreads();
            if (EN(4)) REP(4) for (int it = vcu; it < LRU_NC * 8; it += G) lru_block_item<false>(p, l, lds, it >> 3, it & 7, wave, lane);
            __syncthreads();
            if (EN(5)) REP(5) for (int it = gw; it < S5_NC * 32; it += NGW) s5_item<false>(p, l, lds + wave * S5_WAVE_LDS, it >> 5, it & 31, lane);
            if (EN(6)) REP(6) phase_mixa(p, l, vcu, G, tid);
        } SEAM(pb + 1);
        if (IN(pb + 2)) { IDS();
            if (EN(7)) REP(7) for (int it = gw; it < S5_NC * 32; it += NGW) s5_item<true>(p, l, lds + wave * S5_WAVE_LDS, it >> 5, it & 31, lane);
            __syncthreads();
            if (EN(8)) REP(8) for (int it = vcu; it < LRU_NC * 8; it += G) lru_block_item<true>(p, l, lds, it >> 3, it & 7, wave, lane);
            if (EN(9)) REP(9) phase_attn_combine(p, vcu, G, tid);
        } SEAM(pb + 2);
        if (EN(10) && IN(pb + 3)) REP(10) { IDS();
            __syncthreads();
            pg8::Gemm g{(const pg8::bf16_t*)(p.ws + WS_YG), (const pg8::bf16_t*)(p.ws + WS_WGLU) + (size_t)l * BR * BR, SEQ, BR, BR}; pg8::StaticOrder S; S.init(SEQ, BR, G, bid);
            pg8::EpiGlu E{(pg8::bf16_t*)(p.ws + WS_H) + 3 * BR, DM, (const pg8::bf16_t*)(p.ws + WS_YG), BR, (const pg8::bf16_t*)(p.ws + WS_PROJ) + COL_DG, NIN, p.in[I_S5BGLU] + (size_t)l * BR};
            pg8::gemm_phase<pg8::EpiGlu, pg8::StaticOrder, true, true>(lds, g, S, E);
        } SEAM(pb + 3);
        if (EN(11) && IN(pb + 4)) REP(11) { IDS();
            pg8::Gemm g{(const pg8::bf16_t*)(p.ws + WS_H), (const pg8::bf16_t*)(p.ws + WS_WOUT) + (size_t)l * DM * DM, SEQ, DM, DM}; pg8::StaticOrder S; S.init(SEQ, DM, G, bid);
            pg8::EpiRes E{l == 0 ? p.in[I_X] : p.out, (float*)(p.ws + WS_Z), DM, (const float*)(p.ws + WS_ADAF) + (size_t)l * NIN + 2 * DM, ALPHA};
            pg8::gemm_phase<pg8::EpiRes, pg8::StaticOrder, true, true>(lds, g, S, E);
        } SEAM(pb + 4);
        if (EN(12) && IN(pb + 5)) REP(12) { IDS(); phase_ln(p, l, gw, NGW, lane); } SEAM(pb + 5);
    }
#undef IN
#undef EN
#undef REP
#undef IDS
#undef SEAM
}

extern "C" void kernel_launch(void* const* d_in, const int* in_sizes, int n_in, void* d_out, int out_size, void* d_ws, size_t ws_size, hipStream_t stream) {
    static int grid = 0;
    if (grid == 0) {
        if (n_in != 27 || out_size != SEQ * DM || ws_size < WS_END) { fprintf(stderr, "kernel_launch: unexpected problem (n_in %d, out %d, ws %zu); nothing launched\n", n_in, out_size, ws_size); grid = -1; return; }
        int dev = 0, cus = 0, per_cu = 0;
        if (hipGetDevice(&dev) != hipSuccess || hipDeviceGetAttribute(&cus, hipDeviceAttributeMultiprocessorCount, dev) != hipSuccess) { grid = -1; return; }
        if (hipFuncSetAttribute((const void*)mk_fwd, hipFuncAttributeMaxDynamicSharedMemorySize, LDS_BYTES) != hipSuccess) { fprintf(stderr, "kernel_launch: hipFuncSetAttribute failed\n"); grid = -1; return; }
        if (hipOccupancyMaxActiveBlocksPerMultiprocessor(&per_cu, (const void*)mk_fwd, NTHR, LDS_BYTES) != hipSuccess || per_cu < 1) { fprintf(stderr, "kernel_launch: occupancy query says %d blocks per CU\n", per_cu); }
        (void)hipGetLastError();
        grid = cus;
    }
    if (grid < 0) return;
    (void)hipMemsetAsync((char*)d_ws + WS_CTL, 0, CTL_ZERO_BYTES, stream);
    Params a{};
    for (int i = 0; i < 27; ++i) a.in[i] = (const float*)d_in[i];
    a.out = (float*)d_out; a.ws = (unsigned char*)d_ws;
#if MK_FUSED
    a.ph_lo = 0; a.ph_hi = NPHASE;
    hipLaunchKernelGGL(mk_fwd, dim3(grid), dim3(NTHR), LDS_BYTES, stream, a);
#else
    for (int k = 0; k < NPHASE; ++k) { a.ph_lo = k; a.ph_hi = k + 1; hipLaunchKernelGGL(mk_fwd, dim3(grid), dim3(NTHR), LDS_BYTES, stream, a); }
#endif
}
```
